# Optimizing an MI355X kernel written in HIP

```python
import math
import jax, jax.numpy as jnp
from jax import lax
import numpy as np

D_MODEL = 1024
BATCH = 2
SEQ = 16384
DEPTH = 2

N_HEADS_ATTN = 8
HEAD_DIM = 64
V_DIM = 2 * HEAD_DIM
QK_WIDTH = N_HEADS_ATTN * 2 * HEAD_DIM
ATTN_WIDTH = N_HEADS_ATTN * V_DIM
Q_BLOCK = 128
N_BUCKETS = 32
MAX_DISTANCE = 128
CONV_WIDTH = D_MODEL
CONV_K = 3
IN_SPLITS = (QK_WIDTH, 2 * QK_WIDTH, 2 * QK_WIDTH + ATTN_WIDTH,
             2 * QK_WIDTH + ATTN_WIDTH + CONV_WIDTH,
             2 * QK_WIDTH + ATTN_WIDTH + 2 * CONV_WIDTH,
             2 * QK_WIDTH + ATTN_WIDTH + 3 * CONV_WIDTH,
             2 * QK_WIDTH + ATTN_WIDTH + 3 * CONV_WIDTH + D_MODEL)
IN_COLS = 2 * QK_WIDTH + ATTN_WIDTH + 3 * CONV_WIDTH + 2 * D_MODEL
N_GROUPS = 4
EXPERTS_PER_GROUP = 8
N_EXPERTS = N_GROUPS * EXPERTS_PER_GROUP
TOP_K_IN_GROUP = 2
D_EXPERT = 512
EXPERT_BLOCK = 128
LN_EPS = 1e-5
DN_ALPHA = (2 * DEPTH) ** 0.25
DN_BETA = (8 * DEPTH) ** -0.25

kernel_name = "hybrid_diffattn_shortconv_hmoe_deepnorm"


def layer_norm(x, g, b):
    x32 = x.astype(jnp.float32)
    mu = jnp.mean(x32, axis=-1, keepdims=True)
    var = jnp.mean(jnp.square(x32 - mu), axis=-1, keepdims=True)
    return ((x32 - mu) * lax.rsqrt(var + LN_EPS)).astype(x.dtype) * g + b


def rms_norm(x, g):
    x32 = x.astype(jnp.float32)
    ms = jnp.mean(jnp.square(x32), axis=-1, keepdims=True)
    return (x32 * lax.rsqrt(ms + LN_EPS)).astype(x.dtype) * g


def rel_bucket(rel):
    n = jnp.maximum(rel, 0)
    max_exact = N_BUCKETS // 2
    nf = jnp.maximum(n, 1).astype(jnp.float32)
    large = max_exact + (jnp.log(nf / max_exact) / math.log(MAX_DISTANCE / max_exact)
                         * (N_BUCKETS - max_exact)).astype(jnp.int32)
    large = jnp.minimum(large, N_BUCKETS - 1)
    return jnp.where(n < max_exact, n, large)


def diff_attention(q, k, v, lam, rel_table):
    B, S = q.shape[:2]
    nb = S // Q_BLOCK
    scale = HEAD_DIM ** -0.5
    k1, k2 = k[:, :, :, 0], k[:, :, :, 1]
    kpos = jnp.arange(S, dtype=jnp.int32)
    qb = q.reshape(B, nb, Q_BLOCK, N_HEADS_ATTN, 2, HEAD_DIM).transpose(1, 0, 2, 3, 4, 5)
    starts = jnp.arange(nb, dtype=jnp.int32) * Q_BLOCK

    def block(args):
        qblk, start = args
        qpos = start + jnp.arange(Q_BLOCK, dtype=jnp.int32)
        rel = qpos[:, None] - kpos[None, :]
        bias = jnp.transpose(rel_table[rel_bucket(rel)], (2, 0, 1)).astype(jnp.float32)
        causal = rel >= 0

        def probs(qh, kh):
            s = jnp.einsum('bqhd,bkhd->bhqk', qh, kh).astype(jnp.float32) * scale + bias
            return jax.nn.softmax(jnp.where(causal, s, -jnp.inf), axis=-1)

        a = probs(qblk[:, :, :, 0], k1) - lam * probs(qblk[:, :, :, 1], k2)
        return jnp.einsum('bhqk,bkhe->bqhe', a.astype(v.dtype), v)

    out = lax.map(block, (qb, starts))
    return out.transpose(1, 0, 2, 3, 4).reshape(B, S, N_HEADS_ATTN, V_DIM)


def short_conv(u, w):
    return lax.conv_general_dilated(u, w[:, None, :], window_strides=(1,),
                                    padding=((CONV_K - 1, 0),),
                                    dimension_numbers=('NWC', 'WIO', 'NWC'),
                                    feature_group_count=u.shape[-1])


def mixer(h, layer, w_in, gate_b, lam_vecs, subln_g, w_attn_proj, conv_w, w_conv_proj, w_out, rel_table):
    B, S, _ = h.shape
    z = h @ w_in
    q, k, v, cb, cc, cx, ga, gc = jnp.split(z, IN_SPLITS, axis=-1)
    lam_init = 0.8 - 0.6 * math.exp(-0.3 * layer)
    lv = lam_vecs.astype(jnp.float32)
    lam = jnp.exp(jnp.sum(lv[0] * lv[1])) - jnp.exp(jnp.sum(lv[2] * lv[3])) + lam_init
    o = diff_attention(q.reshape(B, S, N_HEADS_ATTN, 2, HEAD_DIM),
                       k.reshape(B, S, N_HEADS_ATTN, 2, HEAD_DIM),
                       v.reshape(B, S, N_HEADS_ATTN, V_DIM), lam, rel_table)
    o = (rms_norm(o, subln_g) * (1.0 - lam_init)).reshape(B, S, ATTN_WIDTH) @ w_attn_proj
    yc = (cb * short_conv(cc * cx, conv_w)) @ w_conv_proj
    m = jax.nn.sigmoid(ga + gate_b[0]) * o + jax.nn.sigmoid(gc + gate_b[1]) * yc
    return m @ w_out


def hier_moe(x, w_rg, b_rg, w_re, b_re, w1, w3, w2):
    B, S, D = x.shape
    n_tok = B * S
    n_asg = n_tok * TOP_K_IN_GROUP
    xt = x.reshape(n_tok, D)
    g_prob = jax.nn.softmax((xt @ w_rg + b_rg).astype(jnp.float32), axis=-1)
    g_p, g_idx = lax.top_k(g_prob, 1)
    e_logits = (xt @ w_re + b_re).astype(jnp.float32).reshape(n_tok, N_GROUPS, EXPERTS_PER_GROUP)
    e_logits = jnp.take_along_axis(e_logits, g_idx[:, :, None], axis=1)[:, 0]
    e_p, e_loc = lax.top_k(jax.nn.softmax(e_logits, axis=-1), TOP_K_IN_GROUP)
    gate = g_p * e_p / jnp.sum(e_p, axis=-1, keepdims=True)
    expert = (g_idx * EXPERTS_PER_GROUP + e_loc).reshape(-1)
    order = jnp.argsort(expert)
    e_sorted = expert[order]
    tok = order // TOP_K_IN_GROUP
    sizes = jnp.bincount(expert, length=N_EXPERTS)
    padded = (sizes + EXPERT_BLOCK - 1) // EXPERT_BLOCK * EXPERT_BLOCK
    pad_end = jnp.cumsum(padded)
    pad_start = pad_end - padded
    start = jnp.cumsum(sizes) - sizes
    dest = pad_start[e_sorted] + jnp.arange(n_asg) - start[e_sorted]
    n_blk = (n_asg + N_EXPERTS * (EXPERT_BLOCK - 1) + EXPERT_BLOCK - 1) // EXPERT_BLOCK
    xbuf = jnp.zeros((n_blk * EXPERT_BLOCK, D), x.dtype).at[dest].set(xt[tok])
    blk_e = jnp.minimum(jnp.searchsorted(pad_end, jnp.arange(n_blk) * EXPERT_BLOCK, side='right'),
                        N_EXPERTS - 1)

    def expert_block(args):
        xb, e = args
        return (jax.nn.silu(xb @ w1[e]) * (xb @ w3[e])) @ w2[e]

    ybuf = lax.map(expert_block, (xbuf.reshape(n_blk, EXPERT_BLOCK, D), blk_e)).reshape(-1, D)
    y = ybuf[dest] * gate.reshape(-1)[order][:, None].astype(x.dtype)
    return jnp.zeros_like(xt).at[tok].add(y).reshape(B, S, D)


def setup_inputs(seed: int = 0) -> dict:
    key = jax.random.key(seed)
    ks = jax.random.split(key, 24)

    def nrm(k, shape, scale):
        return jax.random.normal(k, shape, jnp.float32) * scale

    L, D = DEPTH, D_MODEL
    return {
        "x": nrm(ks[0], (BATCH, SEQ, D), 1.0),
        "ln0_g": 1.0 + nrm(ks[1], (D,), 0.02),
        "ln0_b": nrm(ks[2], (D,), 0.02),
        "rel_table": nrm(ks[3], (N_BUCKETS, N_HEADS_ATTN), 0.5),
        "w_in": nrm(ks[4], (L, D, IN_COLS), D ** -0.5),
        "gate_b": nrm(ks[5], (L, 2, D), 0.1),
        "lam_vecs": nrm(ks[6], (L, 4, HEAD_DIM), 0.1),
        "subln_g": 1.0 + nrm(ks[7], (L, V_DIM), 0.02),
        "w_attn_proj": nrm(ks[8], (L, ATTN_WIDTH, D), ATTN_WIDTH ** -0.5),
        "conv_w": nrm(ks[9], (L, CONV_K, CONV_WIDTH), CONV_K ** -0.5),
        "w_conv_proj": nrm(ks[10], (L, CONV_WIDTH, D), CONV_WIDTH ** -0.5),
        "w_out": nrm(ks[11], (L, D, D), D ** -0.5 * DN_BETA),
        "ln1_g": 1.0 + nrm(ks[12], (L, D), 0.02),
        "ln1_b": nrm(ks[13], (L, D), 0.02),
        "w_rg": nrm(ks[14], (L, D, N_GROUPS), D ** -0.5),
        "b_rg": nrm(ks[15], (L, N_GROUPS), 0.01),
        "w_re": nrm(ks[16], (L, D, N_EXPERTS), D ** -0.5),
        "b_re": nrm(ks[17], (L, N_EXPERTS), 0.01),
        "w1": nrm(ks[18], (L, N_EXPERTS, D, D_EXPERT), D ** -0.5),
        "w3": nrm(ks[19], (L, N_EXPERTS, D, D_EXPERT), D ** -0.5),
        "w2": nrm(ks[20], (L, N_EXPERTS, D_EXPERT, D), D_EXPERT ** -0.5 * DN_BETA),
        "ln2_g": 1.0 + nrm(ks[21], (L, D), 0.02),
        "ln2_b": nrm(ks[22], (L, D), 0.02),
    }


def reference(x, ln0_g, ln0_b, rel_table, w_in, gate_b, lam_vecs, subln_g, w_attn_proj, conv_w,
              w_conv_proj, w_out, ln1_g, ln1_b, w_rg, b_rg, w_re, b_re, w1, w3, w2, ln2_g, ln2_b):
    h = layer_norm(x, ln0_g, ln0_b)
    for l in range(DEPTH):
        mix = mixer(h, l, w_in[l], gate_b[l], lam_vecs[l], subln_g[l], w_attn_proj[l],
                    conv_w[l], w_conv_proj[l], w_out[l], rel_table)
        h = layer_norm(DN_ALPHA * h + mix, ln1_g[l], ln1_b[l])
        ffn = hier_moe(h, w_rg[l], b_rg[l], w_re[l], b_re[l], w1[l], w3[l], w2[l])
        h = layer_norm(DN_ALPHA * h + ffn, ln2_g[l], ln2_b[l])
    return h
```

```cpp
#include <hip/hip_runtime.h>
#include <hip/hip_bf16.h>
#include <cstdio>
#include <cstdint>
#include <cmath>

#define ST8_WT(p_, v_) asm volatile("global_store_dwordx2 %0, %1, off sc1" :: "v"((unsigned long long)(uintptr_t)(p_)), "v"(v_) : "memory")
#define ST16_WT(p_, v_) asm volatile("global_store_dwordx4 %0, %1, off sc1\n\ts_nop 1" :: "v"((unsigned long long)(uintptr_t)(p_)), "v"(v_) : "memory")

namespace pg8 {
#define PG8_LAS __attribute__((address_space(3)))
typedef unsigned short bf16_t;
typedef short bf16x8 __attribute__((ext_vector_type(8)));
typedef float f32x4 __attribute__((ext_vector_type(4)));
typedef float f32x2 __attribute__((ext_vector_type(2)));
typedef unsigned u32x4 __attribute__((ext_vector_type(4)));
typedef unsigned u32x2 __attribute__((ext_vector_type(2)));
typedef int v8i32 __attribute__((ext_vector_type(8)));
constexpr int BM = 256, BK = 64, HALF = 128, HTB = HALF * BK * 2  , STAGE_BYTES = 8 * HTB, NXCD = 8, WGM = 8;

__host__ __device__ __forceinline__ int lds_byte(int r, int c) { const int st = (r >> 4) * 2 + (c >> 5), rr = r & 15, cc = c & 31, ob = rr * 64 + cc * 2; return st * 1024 + (ob ^ (((ob >> 9) & 1) << 5)); }
__host__ __device__ __forceinline__ void stage_rc(int b, int& R, int& C) { const int st = b / 1024, sb = b % 1024, swz = sb ^ (((sb >> 9) & 1) << 5); R = (st >> 1) * 16 + swz / 64; C = (st & 1) * 32 + (swz % 64) / 2; }
__host__ __device__ __forceinline__ int perm32(int rho) { const int n = rho >> 4, i = rho & 15; return 8 * (i >> 2) + 4 * n + (i & 3); }

struct Unit { int pm, pn, e, nv, lrow; };

struct StaticOrder {
    int nM, nN, nwg, G, c;
    __host__ __device__ void init(int M, int N, int G_, int c_) { nM = M / BM; nN = N / BM; nwg = nM * nN; G = G_; c = c_; }
    __host__ __device__ bool next(int i, Unit& u) const {
        const long L = (long)i * G + c; if (L >= nwg) return false;
        int wgid = (int)L; { const int q = nwg / NXCD, r = nwg % NXCD, xcd = wgid % NXCD, off = wgid / NXCD; wgid = (xcd < r ? xcd * (q + 1) : r * (q + 1) + (xcd - r) * q) + off; }
        const int nig = WGM * nN, gid = wgid / nig, fm = gid * WGM, gsz = (nM - fm) < WGM ? (nM - fm) : WGM;
        u.pm = fm + ((wgid % nig) % gsz); u.pn = (wgid % nig) / gsz; u.e = 0; u.nv = BM; u.lrow = 0; return true;
    }
};

typedef __bf16 bf16x2_t __attribute__((ext_vector_type(2)));
__device__ __forceinline__ unsigned cvt_pk_bf16(float lo, float hi) { f32x2 v = {lo, hi}; bf16x2_t b = __builtin_convertvector(v, bf16x2_t); return __builtin_bit_cast(unsigned, b); }
__device__ __forceinline__ float sigmoidf_fast(float x) { return __builtin_amdgcn_rcpf(1.0f + __builtin_amdgcn_exp2f(-1.4426950408889634f * x)); }
__device__ __forceinline__ float bf_lo(unsigned w) { return __uint_as_float(w << 16); }
__device__ __forceinline__ float bf_hi(unsigned w) { return __uint_as_float(w & 0xffff0000u); }

#define PG8_FOR_AM _Pragma("unroll") for (int ai = 0; ai < 2; ++ai) _Pragma("unroll") for (int m = 0; m < 4; ++m)

struct EpiQKV {
    static constexpr bool PERM = true;
    bf16_t* O; size_t stride; float scale0;
    __device__ __forceinline__ void operator()(const f32x4 (&acc)[2][2][4][2], const Unit& u, int wr, int wc, int fr, int fq) const {
        const int t = u.pn >> 2; bf16_t* base = O + (size_t)t * stride; const float sc = (t == 0) ? scale0 : 1.0f;
        const int row0 = u.pm * BM + wr * 64 + fr, col0 = (u.pn & 3) * BM + wc * 32 + 8 * fq;
        PG8_FOR_AM { bf16_t* rowp = base + (size_t)(row0 + ai * HALF + m * 16) * 1024 + col0;
#pragma unroll
            for (int bj = 0; bj < 2; ++bj) { const f32x4 v0 = acc[ai][bj][m][0] * sc, v1 = acc[ai][bj][m][1] * sc; u32x4 w;
                w.x = cvt_pk_bf16(v0[0], v0[1]); w.y = cvt_pk_bf16(v0[2], v0[3]); w.z = cvt_pk_bf16(v1[0], v1[1]); w.w = cvt_pk_bf16(v1[2], v1[3]);
                ST16_WT(rowp + bj * HALF, w); } }
    }
};
struct EpiConvGate {
    static constexpr bool PERM = true;
    bf16_t* CB; bf16_t* PB; unsigned char* GB; const float* gb;
    __device__ __forceinline__ void operator()(const f32x4 (&acc)[2][2][4][2], const Unit& u, int wr, int wc, int fr, int fq) const {
        const int row0 = u.pm * BM + wr * 64 + fr;
        if (u.pn < 4) {
            const int col0 = u.pn * BM + wc * 32 + 8 * fq;
            PG8_FOR_AM { bf16_t* rowp = CB + (size_t)(row0 + ai * HALF + m * 16) * 1024 + col0;
#pragma unroll
                for (int bj = 0; bj < 2; ++bj) { const f32x4 v0 = acc[ai][bj][m][0], v1 = acc[ai][bj][m][1]; u32x4 w;
                    w.x = cvt_pk_bf16(v0[0], v0[1]); w.y = cvt_pk_bf16(v0[2], v0[3]); w.z = cvt_pk_bf16(v1[0], v1[1]); w.w = cvt_pk_bf16(v1[2], v1[3]);
                    ST16_WT(rowp + bj * HALF, w); } }
        } else if (u.pn < 12) {
            const int col0 = (u.pn - 4) * HALF + wc * 32 + 8 * fq;
            PG8_FOR_AM { bf16_t* rowp = PB + (size_t)(row0 + ai * HALF + m * 16) * 1024 + col0;
                const f32x4 v0 = acc[ai][0][m][0] * acc[ai][1][m][0], v1 = acc[ai][0][m][1] * acc[ai][1][m][1]; u32x4 w;
                w.x = cvt_pk_bf16(v0[0], v0[1]); w.y = cvt_pk_bf16(v0[2], v0[3]); w.z = cvt_pk_bf16(v1[0], v1[1]); w.w = cvt_pk_bf16(v1[2], v1[3]);
                ST16_WT(rowp, w); }
        } else {
            const int col0 = (u.pn - 12) * BM + wc * 32 + 8 * fq;
            f32x4 bv[2][2];
#pragma unroll
            for (int bj = 0; bj < 2; ++bj)
#pragma unroll
                for (int n = 0; n < 2; ++n) bv[bj][n] = *(const f32x4*)(gb + col0 + bj * HALF + 4 * n);
            PG8_FOR_AM { unsigned char* rowp = GB + (size_t)(row0 + ai * HALF + m * 16) * 2048 + col0;
#pragma unroll
                for (int bj = 0; bj < 2; ++bj) {
                    f32x4 v0 = acc[ai][bj][m][0] + bv[bj][0], v1 = acc[ai][bj][m][1] + bv[bj][1]; unsigned a[4], b[4];
#pragma unroll
                    for (int i = 0; i < 4; ++i) { a[i] = __float_as_uint(fmaxf(sigmoidf_fast(v0[i]) * 255.0f, 1.0f) + 8388608.0f); b[i] = __float_as_uint(fmaxf(sigmoidf_fast(v1[i]) * 255.0f, 1.0f) + 8388608.0f); }
                    const u32x2 w = {__builtin_amdgcn_perm(a[1], a[0], 0x0c0c0400u) | __builtin_amdgcn_perm(a[3], a[2], 0x04000c0cu),
                                     __builtin_amdgcn_perm(b[1], b[0], 0x0c0c0400u) | __builtin_amdgcn_perm(b[3], b[2], 0x04000c0cu)};
                    ST8_WT(rowp + bj * HALF, w); } }
        }
    }
};
struct EpiGateOnly {
    static constexpr bool PERM = true;
    EpiConvGate c;
    __device__ __forceinline__ void operator()(const f32x4 (&acc)[2][2][4][2], const Unit& u, int wr, int wc, int fr, int fq) const { Unit v = u; v.pn = u.pn + 12; c(acc, v, wr, wc, fr, fq); }
};
struct EpiMul {
    static constexpr bool PERM = true;
    bf16_t* O; const bf16_t* G; int ldc;
    __device__ __forceinline__ void operator()(const f32x4 (&acc)[2][2][4][2], const Unit& u, int wr, int wc, int fr, int fq) const {
        const int row0 = u.pm * BM + wr * 64 + fr, col0 = u.pn * BM + wc * 32 + 8 * fq;
#pragma unroll
        for (int ai = 0; ai < 2; ++ai) {
            u32x4 g[4][2];
            if (G) {
#pragma unroll
                for (int m = 0; m < 4; ++m)
#pragma unroll
                    for (int bj = 0; bj < 2; ++bj) g[m][bj] = *(const u32x4*)(G + (size_t)(row0 + ai * HALF + m * 16) * ldc + col0 + bj * HALF);
            }
#pragma unroll
            for (int m = 0; m < 4; ++m) { const size_t off = (size_t)(row0 + ai * HALF + m * 16) * ldc + col0;
#pragma unroll
                for (int bj = 0; bj < 2; ++bj) { f32x4 v0 = acc[ai][bj][m][0], v1 = acc[ai][bj][m][1];
                    if (G) { const u32x4 gg = g[m][bj];
                        v0[0] *= bf_lo(gg.x); v0[1] *= bf_hi(gg.x); v0[2] *= bf_lo(gg.y); v0[3] *= bf_hi(gg.y); v1[0] *= bf_lo(gg.z); v1[1] *= bf_hi(gg.z); v1[2] *= bf_lo(gg.w); v1[3] *= bf_hi(gg.w); }
                    u32x4 w; w.x = cvt_pk_bf16(v0[0], v0[1]); w.y = cvt_pk_bf16(v0[2], v0[3]); w.z = cvt_pk_bf16(v1[0], v1[1]); w.w = cvt_pk_bf16(v1[2], v1[3]);
                    ST16_WT(O + off + bj * HALF, w); } }
        }
    }
};
struct EpiDual {
    static constexpr bool PERM = true; static constexpr bool CHAIN = true;
    bf16_t* O; const unsigned char* G;
    static __device__ __forceinline__ float ub0(unsigned w) { return (float)(w & 0xffu); }
    static __device__ __forceinline__ float ub1(unsigned w) { return (float)((w >> 8) & 0xffu); }
    static __device__ __forceinline__ float ub2(unsigned w) { return (float)((w >> 16) & 0xffu); }
    static __device__ __forceinline__ float ub3(unsigned w) { return (float)(w >> 24); }
    __device__ __forceinline__ void chain(f32x4 (&acc)[2][2][4][2], const Unit& u, int wr, int wc, int fr, int fq) const {
        const int row0 = u.pm * BM + wr * 64 + fr, col0 = u.pn * BM + wc * 32 + 8 * fq;
        if (u.e == 0) {
            u32x2 ga[2][4][2], gc[2][4][2];
#pragma unroll
            for (int ai = 0; ai < 2; ++ai)
#pragma unroll
                for (int m = 0; m < 4; ++m)
#pragma unroll
                    for (int bj = 0; bj < 2; ++bj) { const unsigned char* gp = G + (size_t)(row0 + ai * HALF + m * 16) * 2048 + col0 + bj * HALF;
                        ga[ai][m][bj] = *(const u32x2*)gp; gc[ai][m][bj] = *(const u32x2*)(gp + 1024); }
#pragma unroll
            for (int ai = 0; ai < 2; ++ai)
#pragma unroll
                for (int m = 0; m < 4; ++m)
#pragma unroll
                    for (int bj = 0; bj < 2; ++bj) { const u32x2 a = ga[ai][m][bj], c = gc[ai][m][bj];
                        acc[ai][bj][m][0][0] *= ub0(a.x) * __builtin_amdgcn_rcpf(ub0(c.x)); acc[ai][bj][m][0][1] *= ub1(a.x) * __builtin_amdgcn_rcpf(ub1(c.x));
                        acc[ai][bj][m][0][2] *= ub2(a.x) * __builtin_amdgcn_rcpf(ub2(c.x)); acc[ai][bj][m][0][3] *= ub3(a.x) * __builtin_amdgcn_rcpf(ub3(c.x));
                        acc[ai][bj][m][1][0] *= ub0(a.y) * __builtin_amdgcn_rcpf(ub0(c.y)); acc[ai][bj][m][1][1] *= ub1(a.y) * __builtin_amdgcn_rcpf(ub1(c.y));
                        acc[ai][bj][m][1][2] *= ub2(a.y) * __builtin_amdgcn_rcpf(ub2(c.y)); acc[ai][bj][m][1][3] *= ub3(a.y) * __builtin_amdgcn_rcpf(ub3(c.y)); }
        } else {
            u32x2 gc[2][4][2];
#pragma unroll
            for (int ai = 0; ai < 2; ++ai)
#pragma unroll
                for (int m = 0; m < 4; ++m)
#pragma unroll
                    for (int bj = 0; bj < 2; ++bj) gc[ai][m][bj] = *(const u32x2*)(G + (size_t)(row0 + ai * HALF + m * 16) * 2048 + 1024 + col0 + bj * HALF);
#pragma unroll
            for (int ai = 0; ai < 2; ++ai)
#pragma unroll
                for (int m = 0; m < 4; ++m)
#pragma unroll
                    for (int bj = 0; bj < 2; ++bj) { const u32x2 c = gc[ai][m][bj]; f32x4 v0 = acc[ai][bj][m][0] * (1.0f / 255.0f), v1 = acc[ai][bj][m][1] * (1.0f / 255.0f);
                        v0[0] *= ub0(c.x); v0[1] *= ub1(c.x); v0[2] *= ub2(c.x); v0[3] *= ub3(c.x); v1[0] *= ub0(c.y); v1[1] *= ub1(c.y); v1[2] *= ub2(c.y); v1[3] *= ub3(c.y);
                        u32x4 w; w.x = cvt_pk_bf16(v0[0], v0[1]); w.y = cvt_pk_bf16(v0[2], v0[3]); w.z = cvt_pk_bf16(v1[0], v1[1]); w.w = cvt_pk_bf16(v1[2], v1[3]);
                        ST16_WT(O + (size_t)(row0 + ai * HALF + m * 16) * 1024 + col0 + bj * HALF, w); }
        }
    }
};
struct EpiResid {
    static constexpr bool PERM = true;
    const bf16_t* H; bf16_t* V; float alpha;
    __device__ __forceinline__ void operator()(const f32x4 (&acc)[2][2][4][2], const Unit& u, int wr, int wc, int fr, int fq) const {
        const int row0 = u.pm * BM + wr * 64 + fr, col0 = u.pn * BM + wc * 32 + 8 * fq;
        u32x4 h[2][4][2];
#pragma unroll
        for (int ai = 0; ai < 2; ++ai)
#pragma unroll
            for (int m = 0; m < 4; ++m)
#pragma unroll
                for (int bj = 0; bj < 2; ++bj) h[ai][m][bj] = *(const u32x4*)(H + (size_t)(row0 + ai * HALF + m * 16) * 1024 + col0 + bj * HALF);
#pragma unroll
        for (int ai = 0; ai < 2; ++ai) {
#pragma unroll
            for (int m = 0; m < 4; ++m)
#pragma unroll
                for (int bj = 0; bj < 2; ++bj) { const u32x4 hh = h[ai][m][bj]; const f32x4 a0 = acc[ai][bj][m][0], a1 = acc[ai][bj][m][1]; u32x4 w;
                    w.x = cvt_pk_bf16(alpha * bf_lo(hh.x) + a0[0], alpha * bf_hi(hh.x) + a0[1]); w.y = cvt_pk_bf16(alpha * bf_lo(hh.y) + a0[2], alpha * bf_hi(hh.y) + a0[3]);
                    w.z = cvt_pk_bf16(alpha * bf_lo(hh.z) + a1[0], alpha * bf_hi(hh.z) + a1[1]); w.w = cvt_pk_bf16(alpha * bf_lo(hh.w) + a1[2], alpha * bf_hi(hh.w) + a1[3]);
                    ST16_WT(V + (size_t)(row0 + ai * HALF + m * 16) * 1024 + col0 + bj * HALF, w); }
        }
    }
};
struct EpiSilu {
    static constexpr bool PERM = true;
    bf16_t* O;
    __device__ __forceinline__ void operator()(const f32x4 (&acc)[2][2][4][2], const Unit& u, int wr, int wc, int fr, int fq) const {
        const int row0 = u.pm * BM + wr * 64 + fr, col0 = u.pn * HALF + wc * 32 + 8 * fq;
        PG8_FOR_AM { bf16_t* rowp = O + (size_t)(row0 + ai * HALF + m * 16) * 512 + col0; f32x4 v0, v1;
#pragma unroll
            for (int i = 0; i < 4; ++i) { const float a0 = acc[ai][0][m][0][i], a1 = acc[ai][0][m][1][i];
                v0[i] = a0 * sigmoidf_fast(a0) * acc[ai][1][m][0][i]; v1[i] = a1 * sigmoidf_fast(a1) * acc[ai][1][m][1][i]; }
            u32x4 w; w.x = cvt_pk_bf16(v0[0], v0[1]); w.y = cvt_pk_bf16(v0[2], v0[3]); w.z = cvt_pk_bf16(v1[0], v1[1]); w.w = cvt_pk_bf16(v1[2], v1[3]);
            ST16_WT(rowp, w); }
    }
};
struct EpiSilu8 {
    static constexpr bool PERM = true;
    unsigned char* O;
    __device__ __forceinline__ void operator()(const f32x4 (&acc)[2][2][4][2], const Unit& u, int wr, int wc, int fr, int fq) const {
        const int row0 = u.pm * BM + wr * 64 + fr, col0 = u.pn * HALF + wc * 32 + 8 * fq;
        PG8_FOR_AM { unsigned char* rowp = O + (size_t)(row0 + ai * HALF + m * 16) * 512 + col0; f32x4 v0, v1;
#pragma unroll
            for (int i = 0; i < 4; ++i) { const float a0 = acc[ai][0][m][0][i], a1 = acc[ai][0][m][1][i];
                v0[i] = a0 * sigmoidf_fast(a0) * acc[ai][1][m][0][i]; v1[i] = a1 * sigmoidf_fast(a1) * acc[ai][1][m][1][i]; }
            int w0 = 0, w1 = 0;
            w0 = __builtin_amdgcn_cvt_pk_fp8_f32(v0[0], v0[1], w0, false); w0 = __builtin_amdgcn_cvt_pk_fp8_f32(v0[2], v0[3], w0, true);
            w1 = __builtin_amdgcn_cvt_pk_fp8_f32(v1[0], v1[1], w1, false); w1 = __builtin_amdgcn_cvt_pk_fp8_f32(v1[2], v1[3], w1, true);
            const u32x2 w = {(unsigned)w0, (unsigned)w1};
            ST8_WT(rowp, w); }
    }
};
struct EpiOut8 {
    static constexpr bool PERM = true;
    unsigned char* O;
    __device__ __forceinline__ void operator()(const f32x4 (&acc)[2][2][4][2], const Unit& u, int wr, int wc, int fr, int fq) const {
        const int row0 = u.pm * BM + wr * 64 + fr, col0 = u.pn * BM + wc * 32 + 8 * fq;
        PG8_FOR_AM { unsigned char* rowp = O + (size_t)(row0 + ai * HALF + m * 16) * 1024 + col0;
#pragma unroll
            for (int bj = 0; bj < 2; ++bj) { const f32x4 v0 = acc[ai][bj][m][0], v1 = acc[ai][bj][m][1]; int w0 = 0, w1 = 0;
                w0 = __builtin_amdgcn_cvt_pk_fp8_f32(v0[0], v0[1], w0, false); w0 = __builtin_amdgcn_cvt_pk_fp8_f32(v0[2], v0[3], w0, true);
                w1 = __builtin_amdgcn_cvt_pk_fp8_f32(v1[0], v1[1], w1, false); w1 = __builtin_amdgcn_cvt_pk_fp8_f32(v1[2], v1[3], w1, true);
                const u32x2 w = {(unsigned)w0, (unsigned)w1};
                ST8_WT(rowp + bj * HALF, w); } }
    }
};

template <int K_> struct ProbDense { static constexpr bool FP8 = false;
    static constexpr int K = K_; static constexpr bool GATHER = false, MOE = false;
    const bf16_t* A; const bf16_t* Bt;
    __device__ __forceinline__ const char* abase(const Unit& u) const { return (const char*)A + (size_t)u.pm * (BM * K * 2); }
    __device__ __forceinline__ const char* bbase(const Unit& u) const { return (const char*)Bt + (size_t)u.pn * (BM * K * 2); }
    __device__ __forceinline__ const int* rows(const Unit&) const { return nullptr; }
};
template <int K_> struct ProbDense8 { static constexpr bool FP8 = true;
    static constexpr int K = K_; static constexpr bool GATHER = false, MOE = false;
    const bf16_t* A; const bf16_t* Bt;
    __device__ __forceinline__ const char* abase(const Unit& u) const { return (const char*)A + (size_t)u.pm * (BM * K * 2); }
    __device__ __forceinline__ const char* bbase(const Unit& u) const { return (const char*)Bt + (size_t)u.pn * (BM * K * 2); }
    __device__ __forceinline__ const int* rows(const Unit&) const { return nullptr; }
};
template <int K_> struct ProbDual { static constexpr bool FP8 = false;
    static constexpr int K = K_; static constexpr bool GATHER = false, MOE = false;
    const bf16_t* A0; const bf16_t* A1; const bf16_t* Bt;
    __device__ __forceinline__ const char* abase(const Unit& u) const { return (const char*)(u.e == 0 ? A0 : A1) + (size_t)u.pm * (BM * K * 2); }
    __device__ __forceinline__ const char* bbase(const Unit& u) const { return (const char*)Bt + (size_t)(u.e * 4 + u.pn) * (BM * K * 2); }
    __device__ __forceinline__ const int* rows(const Unit&) const { return nullptr; }
};
template <int K_, int NT_, bool GATHER_, bool FP8_ = false> struct ProbMoe { static constexpr bool FP8 = FP8_;
    static constexpr int K = K_; static constexpr bool GATHER = GATHER_, MOE = true;
    const bf16_t* A; const bf16_t* Bt; const int* rowtok; int cap;
    __device__ __forceinline__ const char* abase(const Unit& u) const { return GATHER ? (const char*)A : (const char*)A + (size_t)u.pm * (BM * K * 2); }
    __device__ __forceinline__ const char* bbase(const Unit& u) const { return (const char*)Bt + (size_t)(u.e * NT_ + u.pn) * (BM * K * 2); }
    __device__ __forceinline__ const int* rows(const Unit& u) const { return rowtok + (size_t)u.e * cap + u.lrow; }
};
struct DualOrder {
    StaticOrder S;
    __device__ __forceinline__ bool next(int i, Unit& u) const { if (!S.next(i >> 1, u)) return false; u.e = i & 1; return true; }
};
struct MoeOrder {
    const PG8_LAS int* tp; const PG8_LAS int* cnt; const PG8_LAS int* tt; int ncol, G, c;
    __device__ __forceinline__ bool next(int i, Unit& u) const {
        const int L = i * G + c; const int total = tp[32] * ncol; if (L >= total) return false;
        const int rt = L / ncol; u.pn = L - rt * ncol; const int ent = tt[rt], e = ent >> 16, tile = ent & 0xffff;
        u.pm = tp[e] + tile; u.e = e; u.lrow = tile * BM; const int rem = cnt[e] - u.lrow; u.nv = rem < BM ? rem : BM; return true;
    }
};

template <class E, class = void> struct is_chain { static constexpr bool value = false; };
template <class E> struct is_chain<E, decltype((void)E::CHAIN)> { static constexpr bool value = true; };
template <class Epi, class Prob, class Sched, bool ALIGN_EPI = true, bool SP2 = true>
__device__ __forceinline__ void gemm_phase(PG8_LAS unsigned char* lds, const Prob& P, const Sched& S, const Epi& E) {
    int tid_ = threadIdx.x; asm volatile("" : "+v"(tid_));
    const int tid = tid_, wid = __builtin_amdgcn_readfirstlane(tid >> 6), lane = tid & 63, wr = wid >> 2, wc = wid & 3, fr = lane & 15, fq = lane >> 4;
    constexpr int K = Prob::K, nt = K / BK;
    unsigned voffB[2], Cc[2]; int Rr[2];
#pragma unroll
    for (int i = 0; i < 2; ++i) { int R, C; stage_rc(tid * 16 + i * 8192, R, C); const int Rb = Epi::PERM ? ((R & ~31) + perm32(R & 31)) : R;
        voffB[i] = (unsigned)(Rb * K + C) * 2u; Rr[i] = R; Cc[i] = (unsigned)C * 2u; }
    constexpr size_t kstep = (size_t)(BK * 2);
    constexpr unsigned hstep = (unsigned)HALF * K * 2;
    const unsigned ldsw = (unsigned)wid * 1024u;
    const int aoff = lds_byte(wr * 64 + fr, fq * 8), boff = lds_byte(wc * 32 + fr, fq * 8);
    const int aoff8 = lds_byte(wr * 64 + fr, (fq >> 1) * 32 + (fq & 1) * 16), boff8 = lds_byte(wc * 32 + fr, (fq >> 1) * 32 + (fq & 1) * 16);
#define PG8_SA(b, h) (((b) * 2 + (h)) * HTB)
#define PG8_SB(b, h) ((4 + (b) * 2 + (h)) * HTB)
#define PG8_STAGE(bufoff, gbase, voff) do { _Pragma("unroll") for (int _i = 0; _i < 2; ++_i) \
        __builtin_amdgcn_global_load_lds((const unsigned*)((const char*)(gbase) + (voff)[_i]), (PG8_LAS unsigned*)(lds + (bufoff) + ldsw + _i * 8192), 16, 0, 0); } while (0)
#define PG8_LD8(p_) ({ typedef int v4i32_ __attribute__((ext_vector_type(4))); const v4i32_ lo_ = *(const PG8_LAS v4i32_*)(p_), hi_ = *(const PG8_LAS v4i32_*)((p_) + 16); __builtin_shufflevector(lo_, hi_, 0, 1, 2, 3, 4, 5, 6, 7); })
#define PG8_LDA(dst, b, h) do { if constexpr (Prob::FP8) { _Pragma("unroll") for (int m = 0; m < 4; ++m) dst##_8[m] = PG8_LD8(lds + PG8_SA(b, h) + aoff8 + m * 2048); } \
        else { _Pragma("unroll") for (int m = 0; m < 4; ++m) _Pragma("unroll") for (int k = 0; k < 2; ++k) dst[m][k] = *(const PG8_LAS bf16x8*)(lds + PG8_SA(b, h) + aoff + m * 2048 + k * 1024); } } while (0)
#define PG8_LDB(dst, b, h) do { if constexpr (Prob::FP8) { _Pragma("unroll") for (int n = 0; n < 2; ++n) dst##_8[n] = PG8_LD8(lds + PG8_SB(b, h) + boff8 + n * 2048); } \
        else { _Pragma("unroll") for (int n = 0; n < 2; ++n) _Pragma("unroll") for (int k = 0; k < 2; ++k) dst[n][k] = *(const PG8_LAS bf16x8*)(lds + PG8_SB(b, h) + boff + n * 2048 + k * 1024); } } while (0)
#define PG8_MMA(ai, bj, At, Bt) do { __builtin_amdgcn_s_setprio(1); \
        if constexpr (Prob::FP8) { _Pragma("unroll") for (int m = 0; m < 4; ++m) _Pragma("unroll") for (int n = 0; n < 2; ++n) \
            asm volatile("v_mfma_scale_f32_16x16x128_f8f6f4 %0, %1, %2, %0, %3, %4 op_sel_hi:[0,0,0]" : "+v"(acc[ai][bj][m][n]) : "v"(Bt##_8[n]), "v"(At##_8[m]), "v"(sc_w8), "v"(sc_a8)); } \
          \
        else { _Pragma("unroll") for (int m = 0; m < 4; ++m) _Pragma("unroll") for (int n = 0; n < 2; ++n) _Pragma("unroll") for (int k = 0; k < 2; ++k) \
            acc[ai][bj][m][n] = __builtin_amdgcn_mfma_f32_16x16x32_bf16(Bt[n][k], At[m][k], acc[ai][bj][m][n], 0, 0, 0); } \
        __builtin_amdgcn_s_setprio(0); } while (0)
#define PG8_WAIT_V(n) asm volatile("s_waitcnt vmcnt(" #n ")" ::: "memory")
#define PG8_WAIT_L(n) asm volatile("s_waitcnt lgkmcnt(" #n ")" ::: "memory")
#define PG8_BAR __builtin_amdgcn_s_barrier()
#define PG8_SCHED __builtin_amdgcn_sched_barrier(0)
#define PG8_LOADVA(va, u) do { if constexpr (Prob::GATHER) { const int* rl_ = P.rows(u); \
        _Pragma("unroll") for (int h_ = 0; h_ < 2; ++h_) _Pragma("unroll") for (int i_ = 0; i_ < 2; ++i_) { const int r_ = h_ * HALF + Rr[i_]; const int tok_ = (r_ < (u).nv) ? rl_[r_] : 0; \
            va[h_][i_] = (unsigned)tok_ * (unsigned)(K * 2) + Cc[i_]; } } \
      else { _Pragma("unroll") for (int h_ = 0; h_ < 2; ++h_) _Pragma("unroll") for (int i_ = 0; i_ < 2; ++i_) va[h_][i_] = (unsigned)(Rr[i_] * K * 2) + Cc[i_] + (unsigned)h_ * hstep; } } while (0)
    Unit cur, nxt; int ui = 0;
    if (!S.next(0, cur)) return;
    f32x4 acc[2][2][4][2];
#pragma unroll
    for (int a = 0; a < 2; ++a)
#pragma unroll
        for (int b = 0; b < 2; ++b)
#pragma unroll
            for (int m = 0; m < 4; ++m)
#pragma unroll
                for (int n = 0; n < 2; ++n) acc[a][b][m][n] = (f32x4){0.f, 0.f, 0.f, 0.f};
    bf16x8 At[4][2], B0[2][2], B1[2][2]; v8i32 At_8[4], B0_8[2], B1_8[2];
    int sc_w8 = 0x7a7a7a7a, sc_a8 = 0x7f7f7f7f;
    unsigned vaC[2][2], vaN[2][2];
    PG8_LOADVA(vaC, cur);
    const char* cA = P.abase(cur); const char* cB = P.bbase(cur);
    PG8_STAGE(PG8_SB(0, 0), cB, voffB); PG8_STAGE(PG8_SB(0, 1), cB + hstep, voffB); PG8_STAGE(PG8_SA(0, 0), cA, vaC[0]); PG8_STAGE(PG8_SA(0, 1), cA, vaC[1]);
    if (wr == 1) PG8_BAR;
    PG8_WAIT_V(2); PG8_BAR;
    PG8_STAGE(PG8_SB(1, 0), cB + kstep, voffB); PG8_STAGE(PG8_SA(1, 0), cA + kstep, vaC[0]); PG8_STAGE(PG8_SB(1, 1), cB + hstep + kstep, voffB);
    PG8_WAIT_V(6); PG8_BAR;
    for (;;) {
        const bool has_next = S.next(ui + 1, nxt);
        const bool lower_half = !Prob::MOE || cur.nv > HALF;
        const char* nA = has_next ? P.abase(nxt) : cA; const char* nB = has_next ? P.bbase(nxt) : cB;
        if constexpr (Prob::GATHER) { if (has_next) { PG8_LOADVA(vaN, nxt); } else {
#pragma unroll
            for (int h = 0; h < 2; ++h)
#pragma unroll
                for (int i = 0; i < 2; ++i) vaN[h][i] = vaC[h][i]; } }

#pragma unroll 1
        for (int t = 0; t < nt; t += 2) {
            const bool last = (t == nt - 2);
            const char* a1 = cA + (size_t)(t + 1) * kstep;
            const char* a2 = last ? nA : cA + (size_t)(t + 2) * kstep; const char* b2 = last ? nB : cB + (size_t)(t + 2) * kstep;
            const char* a3 = a2 + kstep; const char* b3 = b2 + kstep;
            unsigned v2[2][2];
#pragma unroll
            for (int h = 0; h < 2; ++h)
#pragma unroll
                for (int i = 0; i < 2; ++i) { if constexpr (Prob::GATHER) v2[h][i] = last ? vaN[h][i] : vaC[h][i]; else v2[h][i] = vaC[h][i]; }
            PG8_LDB(B0, 0, 0); PG8_LDB(B1, 0, 1); PG8_SCHED; PG8_LDA(At, 0, 0); PG8_STAGE(PG8_SA(1, 1), a1, vaC[1]);
            PG8_WAIT_V(8); PG8_WAIT_L(0); PG8_BAR; PG8_MMA(0, 0, At, B0); PG8_MMA(0, 1, At, B1); PG8_BAR; PG8_SCHED;
            PG8_LDA(At, 0, 1); PG8_STAGE(PG8_SB(0, 0), b2, voffB); PG8_STAGE(PG8_SB(0, 1), b2 + hstep, voffB); PG8_STAGE(PG8_SA(0, 0), a2, v2[0]);
            PG8_WAIT_V(8); PG8_WAIT_L(0); PG8_BAR; if (lower_half) { PG8_MMA(1, 0, At, B0); PG8_MMA(1, 1, At, B1); } PG8_BAR; PG8_SCHED;
            PG8_LDB(B0, 1, 0); PG8_LDB(B1, 1, 1); PG8_SCHED; PG8_LDA(At, 1, 0); PG8_STAGE(PG8_SA(0, 1), a2, v2[1]);
            PG8_WAIT_V(8); PG8_WAIT_L(0); PG8_BAR; PG8_MMA(0, 0, At, B0); PG8_MMA(0, 1, At, B1); PG8_BAR; PG8_SCHED;
            PG8_LDA(At, 1, 1); PG8_STAGE(PG8_SB(1, 0), b3, voffB); PG8_STAGE(PG8_SB(1, 1), b3 + hstep, voffB); PG8_STAGE(PG8_SA(1, 0), a3, v2[0]);
            PG8_WAIT_V(8); PG8_WAIT_L(0); PG8_BAR; if (lower_half) { PG8_MMA(1, 0, At, B0); PG8_MMA(1, 1, At, B1); } PG8_BAR; PG8_SCHED;
        }
        if constexpr (ALIGN_EPI) { if (wr == 0) PG8_BAR; }
        if constexpr (Prob::FP8) asm volatile("s_nop 15\n\ts_nop 15\n\ts_nop 7" ::: "memory");
        if constexpr (is_chain<Epi>::value) E.chain(acc, cur, wr, wc, fr, fq); else E(acc, cur, wr, wc, fr, fq);
        if (!has_next) break;
        if (!(is_chain<Epi>::value && cur.e == 0))
#pragma unroll
        for (int a = 0; a < 2; ++a)
#pragma unroll
            for (int b = 0; b < 2; ++b)
#pragma unroll
                for (int m = 0; m < 4; ++m)
#pragma unroll
                    for (int n = 0; n < 2; ++n) acc[a][b][m][n] = (f32x4){0.f, 0.f, 0.f, 0.f};
        cur = nxt; cA = nA; cB = nB; ++ui;
        if constexpr (Prob::GATHER) {
#pragma unroll
            for (int h = 0; h < 2; ++h)
#pragma unroll
                for (int i = 0; i < 2; ++i) vaC[h][i] = vaN[h][i]; }
        if constexpr (ALIGN_EPI) { if (wr == 1) PG8_BAR; }
    }
    PG8_WAIT_V(0);
    if constexpr (!ALIGN_EPI) { if (wr == 0) PG8_BAR; }
    PG8_BAR;
#undef PG8_SA
#undef PG8_SB
#undef PG8_STAGE
#undef PG8_LDA
#undef PG8_LDB
#undef PG8_MMA
#undef PG8_WAIT_V
#undef PG8_WAIT_L
#undef PG8_BAR
#undef PG8_SCHED
#undef PG8_LOADVA
}
}
namespace attn_body {
using bf16=__hip_bfloat16;
using bf16x8=__attribute__((ext_vector_type(8)))short;
using s16x4=__attribute__((ext_vector_type(4)))short;
using f32x16=__attribute__((ext_vector_type(16)))float;
using u32x4=__attribute__((ext_vector_type(4)))unsigned;
constexpr int SEQ=16384,D=64,DV=128,DM=1024;
constexpr int NW=8,QBLK=32,QB=QBLK*NW,KVBLK=64,NQB=SEQ/QB;
constexpr int ATTN_PITCH=DM, ATTN_UNIT_ROWS=QB;
__device__ __forceinline__ int crow(int r,int hi){return (r&3)+8*(r>>2)+4*hi;}
#define SBAR() __builtin_amdgcn_sched_barrier(0)
typedef const __attribute__((address_space(3))) float* lds_cfptr;
constexpr int TBP=96, TBW=320;
#define CMB 4
__device__ __forceinline__ void cmask(f32x16&p0,f32x16&p1,int jb,int qrel,int hi,int wid,lds_cfptr tb){
  const int minD=wid*32-64*jb-63;
  if(minD>=127)return;
  if(minD<-94){
    #pragma unroll
    for(int r=0;r<16;++r){p0[r]=-INFINITY;p1[r]=-INFINITY;}
    return;}
  const lds_cfptr bp=tb+(qrel-64*jb-4*hi+(TBP-59));
  #pragma unroll
  for(int g=0;g<16;g+=CMB){ float t0[CMB],t1[CMB];
    #pragma unroll
    for(int q=0;q<CMB;++q){const int r=g+q,c=(r&3)+8*(r>>2); t0[q]=bp[59-c]; t1[q]=bp[27-c];}
    #if CMB==8
    asm volatile("":"+v"(t0[0]),"+v"(t0[1]),"+v"(t0[2]),"+v"(t0[3]),"+v"(t0[4]),"+v"(t0[5]),"+v"(t0[6]),"+v"(t0[7]),"+v"(t1[0]),"+v"(t1[1]),"+v"(t1[2]),"+v"(t1[3]),"+v"(t1[4]),"+v"(t1[5]),"+v"(t1[6]),"+v"(t1[7]));
    #else
    asm volatile("":"+v"(t0[0]),"+v"(t0[1]),"+v"(t0[2]),"+v"(t0[3]),"+v"(t1[0]),"+v"(t1[1]),"+v"(t1[2]),"+v"(t1[3]));
    #endif
    #pragma unroll
    for(int q=0;q<CMB;++q){p0[g+q]+=t0[q]; p1[g+q]+=t1[q];} }
}

constexpr int NSLOT=3, KSLOT=8192, VSLOT=16384;
constexpr int LDS_K=0, LDS_V=NSLOT*KSLOT, LDS_WS=LDS_V+NSLOT*VSLOT, LDS_OST=LDS_WS+NW*64*4, LDS_BYTES=LDS_OST+NW*8192;
constexpr int LDS_VOTE=152576;
constexpr float C2=0.125f*1.4426950408889634f;
template<int OFF> __device__ __forceinline__ void glds16(const void*sbase,unsigned voff,unsigned lds_dst){unsigned keep;
  asm volatile("s_mov_b32 %0, m0\n\ts_mov_b32 m0, %2\n\ts_nop 0\n\tglobal_load_lds_dwordx4 %1, %3 offset:%c4\n\ts_mov_b32 m0, %0":"=&s"(keep):"v"(voff),"s"(lds_dst),"s"(sbase),"i"(OFF):"memory");}
__device__ __forceinline__ float max3f(float a,float b,float c){float r;asm("v_max3_f32 %0, %1, %2, %3":"=v"(r):"v"(a),"v"(b),"v"(c));return r;}
__device__ __forceinline__ float max2f(float a,float b){float r;asm("v_max_f32_e32 %0, %1, %2":"=v"(r):"v"(a),"v"(b));return r;}
typedef float f32x2_t __attribute__((ext_vector_type(2))); typedef __bf16 bf16x2_t __attribute__((ext_vector_type(2)));
__device__ __forceinline__ unsigned cvtpk_s(float lo,float hi){f32x2_t v={lo,hi};bf16x2_t b=__builtin_convertvector(v,bf16x2_t);return __builtin_bit_cast(unsigned,b);}
#define WAIT_BAR(N) asm volatile("s_waitcnt vmcnt(" #N ") lgkmcnt(0)\n\ts_barrier":::"memory")
#define MFMA32(a,b,c) __builtin_amdgcn_mfma_f32_32x32x16_bf16(a,b,c,0,0,0)

__device__ __forceinline__ void qkt(f32x16&p0,f32x16&p1,const char*Kslot,const bf16x8*qr,int r32,int hi){
  const char*kb=Kslot+hi*1024+r32*16; const f32x16 z=f32x16{};
  #pragma unroll
  for(int d0=0;d0<4;++d0){
    const bf16x8 b0=*reinterpret_cast<const bf16x8*>(kb+d0*2048);
    const bf16x8 b1=*reinterpret_cast<const bf16x8*>(kb+d0*2048+512);
    if(d0==0){p0=MFMA32(b0,qr[0],z);p1=MFMA32(b1,qr[0],z);}
    else{p0=MFMA32(b0,qr[d0],p0);p1=MFMA32(b1,qr[d0],p1);}}
}
typedef __attribute__((address_space(3))) const char* lds_cptr;
typedef short v4i16_t __attribute__((ext_vector_type(4)));
__device__ __forceinline__ void kload8(bf16x8*kf,lds_cptr kp){
  kf[0]=*(const __attribute__((address_space(3))) bf16x8*)(kp);      kf[1]=*(const __attribute__((address_space(3))) bf16x8*)(kp+512);
  kf[2]=*(const __attribute__((address_space(3))) bf16x8*)(kp+2048); kf[3]=*(const __attribute__((address_space(3))) bf16x8*)(kp+2560);
  kf[4]=*(const __attribute__((address_space(3))) bf16x8*)(kp+4096); kf[5]=*(const __attribute__((address_space(3))) bf16x8*)(kp+4608);
  kf[6]=*(const __attribute__((address_space(3))) bf16x8*)(kp+6144); kf[7]=*(const __attribute__((address_space(3))) bf16x8*)(kp+6656);
}
__device__ __forceinline__ void kload2(bf16x8*kf,lds_cptr kp,int j){ kf[2*j]=*(const __attribute__((address_space(3))) bf16x8*)(kp+j*2048); kf[2*j+1]=*(const __attribute__((address_space(3))) bf16x8*)(kp+j*2048+512); }
__device__ __forceinline__ s16x4 vtr(lds_cptr p){ return __builtin_bit_cast(s16x4,__builtin_amdgcn_ds_read_tr16_b64_v4i16((__attribute__((address_space(3))) v4i16_t*)p)); }
__device__ __forceinline__ float rowmax(const f32x16&p0,const f32x16&p1){
  float a=max3f(p0[0],p0[1],p1[0]),b=max3f(p0[2],p0[3],p1[1]);a=max3f(a,p1[2],p1[3]);
  #pragma unroll
  for(int r=4;r<16;r+=4){a=max3f(a,p0[r],p0[r+1]);b=max3f(b,p0[r+2],p0[r+3]);a=max3f(a,p1[r],p1[r+1]);b=max3f(b,p1[r+2],p1[r+3]);}
  const float m=max2f(a,b);
  auto rr=__builtin_amdgcn_permlane32_swap(__float_as_uint(m),__float_as_uint(m),false,false);
  return max2f(__uint_as_float(rr[0]),__uint_as_float(rr[1]));
}
__device__ __forceinline__ void pv(f32x16*o,int vb,bf16x8 pa0,bf16x8 pa1,bf16x8 pa2,bf16x8 pa3){
  #pragma unroll
  for(int d0=0;d0<4;++d0){s16x4 lo[4],hi[4];
    #pragma unroll
    for(int ks=0;ks<4;++ks){
      asm volatile("ds_read_b64_tr_b16 %0,%1 offset:%c2":"=&v"(lo[ks]):"v"(vb),"i"(d0*4096+ks*1024):"memory");
      asm volatile("ds_read_b64_tr_b16 %0,%1 offset:%c2":"=&v"(hi[ks]):"v"(vb),"i"(d0*4096+ks*1024+512):"memory");}
    asm volatile("s_waitcnt lgkmcnt(0)":::"memory");SBAR();
    #define PK(k) (bf16x8){lo[k][0],lo[k][1],lo[k][2],lo[k][3],hi[k][0],hi[k][1],hi[k][2],hi[k][3]}
    o[d0]=MFMA32(pa0,PK(0),o[d0]);
    o[d0]=MFMA32(pa1,PK(1),o[d0]);
    o[d0]=MFMA32(pa2,PK(2),o[d0]);
    o[d0]=MFMA32(pa3,PK(3),o[d0]);
    #undef PK
  }
}

#ifndef ATTN_STORE16
#define ATTN_STORE16(p,v) ST16_WT(p,v)
#endif
template<int THRL,int VAR,bool FAST> __device__ __forceinline__ bool attn_unit(int b,int hq,int h,int qb,int half,float lam,float osc,const float*subg,const bf16*Q,const bf16*__restrict__ K,const bf16*__restrict__ V,bf16*O,char*shm,lds_cfptr tb){
  int tid_=threadIdx.x; asm volatile("":"+v"(tid_)); const int tid=tid_,lane=tid&63,r32=lane&31,hi=lane>>5; const int wid=__builtin_amdgcn_readfirstlane(tid>>6);
  const long rowbase=(long)b*SEQ; const int q0=qb*QB;
  const bf16*Qw=Q+(rowbase+q0+wid*QBLK)*DM+hq*D;
  const bf16*Kh=K+rowbase*DM+hq*D,*Vh=V+rowbase*DM+h*DV;
  const unsigned lds0=(unsigned)(uintptr_t)shm;
  float*wsf=(float*)(shm+LDS_WS)+wid*64;
  const unsigned kvo=(unsigned)(lane*DM+wid*8)*2u;
  const unsigned vvo=(unsigned)((16*(wid&3)+(lane>>2))*DM+(wid>>2)*32+(lane&3)*8)*2u;
  const unsigned kdst=lds0+LDS_K+wid*1024, vdst=lds0+LDS_V+wid*1024;
  #define DMA_K(t,slot) glds16<0>(Kh+(long)(t)*KVBLK*DM,kvo,(unsigned)__builtin_amdgcn_readfirstlane(kdst+(slot)))
  #define DMA_V0(t,slot) glds16<0>(Vh+(long)(t)*KVBLK*DM,vvo,(unsigned)__builtin_amdgcn_readfirstlane(vdst+2*(slot)))
  #define DMA_V1(t,slot) glds16<0>(Vh+(long)(t)*KVBLK*DM+64,vvo,(unsigned)__builtin_amdgcn_readfirstlane(vdst+2*(slot)+8192))
  #define DMA_V(t,slot) do{ DMA_V0(t,slot); DMA_V1(t,slot); }while(0)
  const char*Kbase=shm+LDS_K; bf16x8 kf[8];
  const lds_cptr shm3=(lds_cptr)shm; const lds_cptr kp0=shm3+LDS_K+hi*1024+r32*16; const lds_cptr vp0=shm3+LDS_V+((lane>>4)&1)*32+(lane&3)*8+(4*hi+((lane&15)>>2))*64;
  const int NT=(q0+QB)/KVBLK;
  DMA_K(0,0);DMA_V(0,0);DMA_K(1,KSLOT);
  bf16x8 qr[4];
  #pragma unroll
  for(int d0=0;d0<4;++d0)qr[d0]=*reinterpret_cast<const bf16x8*>(&Qw[(long)r32*DM+d0*16+hi*8]);
  float mhat=0.f,l_reg=0.f;f32x16 o[4];o[0]=f32x16{};o[1]=f32x16{};o[2]=f32x16{};o[3]=f32x16{};
  bool slow=false;
  const int qrel=wid*QBLK+r32;
  #define CMASK(P0,P1,t) do{int jb_=(t)-(NT-4); if(jb_>=-2)cmask(P0,P1,jb_,qrel,hi,wid,tb);}while(0)
  bool resc=false;
  #define START(P0,P1) do{ resc=false; \
    if constexpr(!FAST){ const float rm=rowmax(P0,P1); \
    if(__builtin_expect(__any(__builtin_fabsf(rm)>(float)THRL),0)){ mhat=rm; slow=true; \
      _Pragma("unroll") for(int r=0;r<16;++r){P0[r]-=rm;P1[r]-=rm;} } } \
    _Pragma("unroll") for(int r=0;r<16;++r)P0[r]=__builtin_amdgcn_exp2f(P0[r]); }while(0)
  #define RESC() do{ if(resc){ asm volatile("s_waitcnt lgkmcnt(0)":::"memory"); \
      _Pragma("unroll") for(int d_=0;d_<4;++d_) _Pragma("unroll") for(int r=0;r<16;++r)o[d_][r]*=wsf[crow(r,hi)]; } }while(0)
  f32x16 pA0,pA1,pB0,pB1; if((VAR)&8){pA0=f32x16{};pA1=f32x16{};pB0=f32x16{};pB1=f32x16{};}
  int sl_prev=0,sl_cur=0,sl_next=KSLOT;
  #define ROT() do{sl_prev=sl_cur;sl_cur=sl_next;sl_next=(sl_next==(NSLOT-1)*KSLOT)?0:sl_next+KSLOT;}while(0)
  DMA_K(2,2*KSLOT);
  WAIT_BAR(4);
  qkt(pA0,pA1,Kbase,qr,r32,hi);asm volatile("s_nop 15\n\ts_nop 7":"+v"(pA0),"+v"(pA1));CMASK(pA0,pA1,0);
  START(pA0,pA1);
  _Pragma("unroll") for(int r=0;r<16;++r)pA1[r]=__builtin_amdgcn_exp2f(pA1[r]);
  WAIT_BAR(0);
  DMA_K(3,0);DMA_V(1,KSLOT);
  ROT();
  kload8(kf,kp0+sl_cur);
  WAIT_BAR(3);
  s16x4 vlo[8],vhi[8]; u32x4 pw0,pw1,pw2,pw3;
  if((VAR)&2){ _Pragma("unroll") for(int i_=0;i_<8;++i_){vlo[i_]=s16x4{};vhi[i_]=s16x4{};} }
  const f32x16 zero16=f32x16{};
  #define PKW(P,B) cvtpk_s(P[B],P[B+1])
  #define PAF(k) __builtin_bit_cast(bf16x8,pw##k)
  #define VFR(i) (bf16x8){vlo[i][0],vlo[i][1],vlo[i][2],vlo[i][3],vhi[i][0],vhi[i][1],vhi[i][2],vhi[i][3]}
  #define PIN(x) asm volatile("":"+v"(x))
  #define MX3(a,b,c) __builtin_fmaxf(__builtin_fmaxf((a),(b)),(c))
  #define GAPA(MF,A0,A1,A2,A3,W0,W1,PW) do{ if(!((VAR)&8)){ MF; } sacc+=A0; sacc+=A1; sacc+=A2; sacc+=A3; PIN(sacc); W0; W1; PIN(PW); SBAR(); }while(0)
  #define EX(v) (((VAR)&1)?(v):__builtin_amdgcn_exp2f(v))
  #define GAPB(MF,X,B) do{ if(!((VAR)&4)){ MF; } X[B]=EX(X[B]); X[B+1]=EX(X[B+1]); PIN(X); SBAR(); }while(0)
  #define GAPB3(MF,X,B) do{ if(!((VAR)&4)){ MF; } X[B]=EX(X[B]); X[B+1]=EX(X[B+1]); X[B+2]=EX(X[B+2]); PIN(X); SBAR(); }while(0)
  #define GAPB3X(MF,XA,XB) do{ if(!((VAR)&4)){ MF; } XA[15]=EX(XA[15]); XB[0]=EX(XB[0]); XB[1]=EX(XB[1]); PIN(XA); PIN(XB); SBAR(); }while(0)
  #define PVA(MF) do{ if(!((VAR)&4)){ MF; } }while(0)
  #define VRD(s,f) do{ if(!((VAR)&2)){ vlo[s]=vtr(vp_+(((f)>>2)*4096+((f)&3)*1024)); vhi[s]=vtr(vp_+(((f)>>2)*4096+((f)&3)*1024+512)); } }while(0)
  #define KRD(G,j) do{ if((G)&&!((VAR)&16)){ kload2(kf,kp0+sl_next,j); SBAR(); } }while(0)
  #define STEP(C0,C1,P0,P1,t,GK,GV,GL) do{ SBAR(); \
    const lds_cptr vp_=vp0+2*sl_prev; \
    VRD(0,0); SBAR(); float sacc=(P0[0]+P0[1]); \
    GAPA(C0=MFMA32(kf[0],qr[0],zero16), P0[2],P0[3],P0[4],P0[5],     pw0[0]=PKW(P0,0), pw0[1]=PKW(P0,2), pw0); \
    VRD(4,4); SBAR(); GAPA(C1=MFMA32(kf[1],qr[0],zero16), P0[6],P0[7],P0[8],P0[9],     pw0[2]=PKW(P0,4), pw0[3]=PKW(P0,6), pw0); \
    VRD(1,1); SBAR(); GAPA(C0=MFMA32(kf[2],qr[1],C0),   P0[10],P0[11],P0[12],P0[13], pw1[0]=PKW(P0,8), pw1[1]=PKW(P0,10), pw1); \
    VRD(5,5); SBAR(); GAPA(C1=MFMA32(kf[3],qr[1],C1),   P0[14],P0[15],P1[0],P1[1],   pw1[2]=PKW(P0,12),pw1[3]=PKW(P0,14), pw1); \
    VRD(2,2); SBAR(); GAPA(C0=MFMA32(kf[4],qr[2],C0),   P1[2],P1[3],P1[4],P1[5],     pw2[0]=PKW(P1,0), pw2[1]=PKW(P1,2), pw2); PVA(o[0]=MFMA32(PAF(0),VFR(0),o[0])); if(!((VAR)&128)){VRD(0,8);}  SBAR(); if((GK)&&!((VAR)&64)){DMA_K((t)+3,sl_cur);SBAR();} \
    VRD(6,6); SBAR(); GAPA(C1=MFMA32(kf[5],qr[2],C1),   P1[6],P1[7],P1[8],P1[9],     pw2[2]=PKW(P1,4), pw2[3]=PKW(P1,6), pw2); PVA(o[1]=MFMA32(PAF(0),VFR(4),o[1])); if(!((VAR)&128)){VRD(4,12);} SBAR(); if((GV)&&!((VAR)&32)){DMA_V0((t)+1,sl_next);SBAR();} \
    VRD(3,3); SBAR(); GAPA(C0=MFMA32(kf[6],qr[3],C0),   P1[10],P1[11],P1[12],P1[13], pw3[0]=PKW(P1,8), pw3[1]=PKW(P1,10), pw3); PVA(o[0]=MFMA32(PAF(1),VFR(1),o[0])); if(!((VAR)&128)){VRD(1,9);}  SBAR(); if((GV)&&!((VAR)&32)){DMA_V1((t)+1,sl_next);SBAR();} \
    VRD(7,7); SBAR(); GAPA(C1=MFMA32(kf[7],qr[3],C1),   P1[14],P1[15],0.f,0.f,       pw3[2]=PKW(P1,12),pw3[3]=PKW(P1,14), pw3); PVA(o[1]=MFMA32(PAF(1),VFR(5),o[1])); if(!((VAR)&128)){VRD(5,13);} SBAR(); \
    l_reg+=sacc; \
    if constexpr(!FAST){ if(__builtin_expect(slow,0)){ _Pragma("unroll") for(int r=0;r<16;++r){C0[r]-=mhat;C1[r]-=mhat;} } } \
    CMASK(C0,C1,t); \
    if constexpr(FAST){ resc=false; } else { float a=MX3(C0[0],C0[1],C1[0]),b=MX3(C0[2],C0[3],C1[1]); a=MX3(a,C1[2],C1[3]); \
      _Pragma("unroll") for(int r=4;r<16;r+=4){a=MX3(a,C0[r],C0[r+1]);b=MX3(b,C0[r+2],C0[r+3]);a=MX3(a,C1[r],C1[r+1]);b=MX3(b,C1[r+2],C1[r+3]);} \
      float rm=__builtin_fmaxf(a,b); { auto rr=__builtin_amdgcn_permlane32_swap(__float_as_uint(rm),__float_as_uint(rm),false,false); rm=__builtin_fmaxf(__uint_as_float(rr[0]),__uint_as_float(rr[1])); } \
      resc=false; \
      if(__builtin_expect(__any(rm>(float)THRL),0)){ const float dl=__builtin_fmaxf(rm,0.f); mhat+=dl; slow=true; \
        _Pragma("unroll") for(int r=0;r<16;++r){C0[r]-=dl;C1[r]-=dl;} \
        const float f=__builtin_amdgcn_exp2f(-dl); l_reg*=f; if(hi==0)wsf[r32]=f; resc=true; } } \
    SBAR(); \
    GAPB3(o[0]=MFMA32(PAF(2),VFR(2),o[0]), C0,0);  VRD(2,10); SBAR(); \
    GAPB3(o[1]=MFMA32(PAF(2),VFR(6),o[1]), C0,3);  VRD(6,14); SBAR(); \
    GAPB3(o[0]=MFMA32(PAF(3),VFR(3),o[0]), C0,6);  VRD(3,11); SBAR(); \
    GAPB3(o[1]=MFMA32(PAF(3),VFR(7),o[1]), C0,9);  VRD(7,15); SBAR(); \
    KRD(GL,0); GAPB3(o[2]=MFMA32(PAF(0),VFR(0),o[2]), C0,12); \
    KRD(GL,1); GAPB3X(o[3]=MFMA32(PAF(0),VFR(4),o[3]), C0,C1); \
    KRD(GL,2); GAPB3(o[2]=MFMA32(PAF(1),VFR(1),o[2]), C1,2); \
    KRD(GL,3); GAPB3(o[3]=MFMA32(PAF(1),VFR(5),o[3]), C1,5); \
    GAPB(o[2]=MFMA32(PAF(2),VFR(2),o[2]), C1,8); \
    GAPB(o[3]=MFMA32(PAF(2),VFR(6),o[3]), C1,10); \
    GAPB(o[2]=MFMA32(PAF(3),VFR(3),o[2]), C1,12); \
    GAPB(o[3]=MFMA32(PAF(3),VFR(7),o[3]), C1,14); \
    }while(0)
  int t=1;
  #undef CMASK
  #define CMASK(P0,P1,t) do{}while(0)
  for(;t+7<NT;t+=2){
    STEP(pB0,pB1,pA0,pA1,t,true,true,true);     WAIT_BAR(3); RESC(); ROT();
    STEP(pA0,pA1,pB0,pB1,t+1,true,true,true);   WAIT_BAR(3); RESC(); ROT();
  }
  #undef CMASK
  #define CMASK(P0,P1,t) do{int jb_=(t)-(NT-4); if(jb_>=-2)cmask(P0,P1,jb_,qrel,hi,wid,tb);}while(0)
  #define ENDW(tt) do{ if((tt)+3<NT){WAIT_BAR(3);} else if((tt)+2<NT){WAIT_BAR(2);} else {WAIT_BAR(0);} }while(0)
  for(;t+1<NT;t+=2){
    STEP(pB0,pB1,pA0,pA1,t,(t+3<NT),(t+1<NT),(t+1<NT));       ENDW(t);   RESC(); ROT();
    STEP(pA0,pA1,pB0,pB1,t+1,(t+4<NT),(t+2<NT),(t+2<NT));     ENDW(t+1); RESC(); ROT();
  }
  STEP(pB0,pB1,pA0,pA1,NT-1,false,false,false); RESC();
  { float sacc=pB0[0]+pB0[1]; _Pragma("unroll") for(int r=2;r<16;++r)sacc+=pB0[r]; _Pragma("unroll") for(int r=0;r<16;++r)sacc+=pB1[r]; l_reg+=sacc;
    pw0=(u32x4){PKW(pB0,0),PKW(pB0,2),PKW(pB0,4),PKW(pB0,6)};pw1=(u32x4){PKW(pB0,8),PKW(pB0,10),PKW(pB0,12),PKW(pB0,14)};pw2=(u32x4){PKW(pB1,0),PKW(pB1,2),PKW(pB1,4),PKW(pB1,6)};pw3=(u32x4){PKW(pB1,8),PKW(pB1,10),PKW(pB1,12),PKW(pB1,14)};
    SBAR(); pv(o,(int)(unsigned)(uintptr_t)(vp0+2*sl_cur),PAF(0),PAF(1),PAF(2),PAF(3)); }
  #undef PKW
  #undef PAF
  #undef VFR
  #undef PIN
  #undef MX3
  #undef GAPA
  #undef GAPB
  #undef GAPB3
  #undef GAPB3X
  #undef PVA
  #undef EX
  #undef VRD
  #undef KRD
  #undef STEP
  #undef ENDW
  {auto rr=__builtin_amdgcn_permlane32_swap(__float_as_uint(l_reg),__float_as_uint(l_reg),false,false);l_reg=__uint_as_float(rr[0])+__uint_as_float(rr[1]);}
  if constexpr(FAST){
    volatile __attribute__((address_space(3))) unsigned*vote=(volatile __attribute__((address_space(3))) unsigned*)((lds_cptr)shm+LDS_VOTE);
    const bool wbad=__any(!(l_reg>=0x1p-80f&&l_reg<=0x1p80f));
    if(lane==0)vote[wid]=wbad?1u:0u;
    asm volatile("s_waitcnt lgkmcnt(0)\n\ts_barrier":::"memory");
    unsigned any_=0u;
    #pragma unroll
    for(int w_=0;w_<NW;++w_)any_|=vote[w_];
    if(__builtin_amdgcn_readfirstlane(any_)!=0u){ asm volatile("s_waitcnt lgkmcnt(0)\n\ts_barrier":::"memory"); return true; }
  }
  if(hi==0)wsf[32+r32]=l_reg;asm volatile("s_waitcnt lgkmcnt(0)":::"memory");
  float rli[16];
  #pragma unroll
  for(int r=0;r<16;++r)rli[r]=__builtin_amdgcn_rcpf(wsf[32+crow(r,hi)]);
  { if(half&&!FAST){ asm volatile("s_waitcnt lgkmcnt(0)\n\ts_barrier":::"memory"); }
    bf16*stg=(bf16*)(shm+(half?LDS_K:LDS_OST))+wid*4096;
    #pragma unroll
    for(int r=0;r<16;++r){const int orow=crow(r,hi);
      #pragma unroll
      for(int d0=0;d0<4;++d0)stg[orow*128+d0*32+r32]=__float2bfloat16(o[d0][r]*rli[r]);}
    if(half){
      asm volatile("s_waitcnt lgkmcnt(0)":::"memory");
      const bf16*stg0=(const bf16*)(shm+LDS_OST)+wid*4096;
      bf16*Ow=O+(rowbase+q0+wid*QBLK)*DM+h*DV; const int ch=lane&15; float gs[8]; float lam_=lam,osc_=osc; asm volatile("":"+v"(lam_),"+v"(osc_));
      #pragma unroll
      for(int i=0;i<8;++i)gs[i]=subg[ch*8+i]*osc_;
      #pragma unroll 2
      for(int i=0;i<8;++i){const int row=i*4+(lane>>4); const u32x4 v0=*(const u32x4*)(stg0+row*128+ch*8), v1=*(const u32x4*)(stg+row*128+ch*8); float x[8]; float ss=0.f;
        #pragma unroll
        for(int q=0;q<4;++q){x[2*q]=__uint_as_float(v0[q]<<16)-lam_*__uint_as_float(v1[q]<<16);x[2*q+1]=__uint_as_float(v0[q]&0xffff0000u)-lam_*__uint_as_float(v1[q]&0xffff0000u);ss+=x[2*q]*x[2*q]+x[2*q+1]*x[2*q+1];}
        ss+=__int_as_float(__builtin_amdgcn_update_dpp(0,__float_as_int(ss),0xB1,0xF,0xF,true)); ss+=__int_as_float(__builtin_amdgcn_update_dpp(0,__float_as_int(ss),0x4E,0xF,0xF,true));
        ss+=__int_as_float(__builtin_amdgcn_update_dpp(0,__float_as_int(ss),0x141,0xF,0xF,true)); ss+=__int_as_float(__builtin_amdgcn_update_dpp(0,__float_as_int(ss),0x140,0xF,0xF,true));
        const float rs=__builtin_amdgcn_rsqf(ss*(1.f/DV)+1e-5f); u32x4 w;
        #pragma unroll
        for(int q=0;q<4;++q)w[q]=cvtpk_s(x[2*q]*rs*gs[2*q],x[2*q+1]*rs*gs[2*q+1]);
        ATTN_STORE16(Ow+(long)row*DM+ch*8,w);}
    } }
  asm volatile("s_waitcnt lgkmcnt(0)\n\ts_barrier":::"memory");
  #undef DMA_K
  #undef DMA_V
  #undef CMASK
  #undef START
  #undef RESC
  #undef ROT
  return false;
}
constexpr int ATTN_LDS_BYTES=LDS_BYTES;
struct AttnTensors { const bf16* Q; const bf16* K; const bf16* V; bf16* O; float lam, osc; const float* subg; };
struct AttnUnit { int b, h, half, qb; };
struct StaticOrder {
  int vcu, G;
  __device__ __forceinline__ explicit StaticOrder(int grid,int vcu_):vcu(vcu_),G(grid){}
  __device__ __forceinline__ bool next(int i,AttnUnit&u)const{ const int idx=vcu+(i>>2)*G; if(idx>=512)return false; const int s=idx&31, x=(idx>>5)&7, ci=idx>>8;
    u.b=x>>2; u.h=(x&3)*2+ci; u.half=i&1; u.qb=(i&2)?63-s:s; return true; }
  __device__ __forceinline__ void a_ready(const AttnUnit&)const{}
  __device__ __forceinline__ void done(const AttnUnit&)const{}
};
template<class Sched,int VAR=0,int THRL=8> __device__ __forceinline__ void attn_phase(char*lds,const AttnTensors&T,const Sched&S,lds_cfptr tball){
  AttnUnit u;
  for(int i=0;S.next(i,u);++i){ S.a_ready(u);
    if(attn_unit<THRL,VAR,true>(u.b,2*u.h+u.half,u.h,u.qb,u.half,T.lam,T.osc,T.subg,T.Q,T.K,T.V,T.O,lds,tball+u.h*TBW))
      attn_unit<THRL,VAR,false>(u.b,2*u.h+u.half,u.h,u.qb,u.half,T.lam,T.osc,T.subg,T.Q,T.K,T.V,T.O,lds,tball+u.h*TBW);
    S.done(u); }
}
#undef SBAR
#undef WAIT_BAR
#undef MFMA32
}

#ifndef PHASES
#define PHASES 0xFFFF
#endif
#ifndef ATTN_PROBE_VAR
#define ATTN_PROBE_VAR 0
#endif
#ifndef REPEAT
#define REPEAT 0x0
#endif
constexpr int NWAVES = 8;
constexpr int BATCH = 2, SEQ = 16384, D = 1024, M = BATCH * SEQ, DEPTH = 2;
constexpr int NH = 8, VD = 128, IN_COLS = 8192, NE = 32, DE = 512;
constexpr float LN_EPS = 1e-5f;
constexpr float DN_ALPHA = 1.4142135623730951f;
constexpr float LOG2E = 1.4426950408889634f;
constexpr int CAP = 32768;
constexpr int MAXROWS = 2 * M + NE * 256;

constexpr size_t MiB = 1u << 20;
constexpr size_t WS_CTL = 0, CTL_ZERO_BYTES = 1 * MiB;
constexpr size_t WS_ROWTOK = 2 * MiB, WS_TOKINFO = 6 * MiB, WS_RIMG = 7 * MiB;
constexpr size_t WS_WIN = 8 * MiB, WS_WAC = 24 * MiB, WS_WOUT2 = 28 * MiB, WS_W13 = 32 * MiB, WS_W2 = 96 * MiB;
constexpr size_t WS_HB = 128 * MiB;
constexpr size_t WS_HB8 = 64 * MiB;
constexpr size_t WS_S0 = 192 * MiB, SLOT = 64 * MiB, WS_END = WS_S0 + 6 * SLOT;
constexpr size_t WS_Q = WS_S0, WS_K = WS_S0 + SLOT, WS_V = WS_S0 + 2 * SLOT, WS_T0 = WS_S0 + 3 * SLOT, WS_T1 = WS_S0 + 4 * SLOT;
constexpr size_t WS_GB = WS_S0, WS_CB = WS_S0 + 2 * SLOT, WS_PB = WS_S0 + 5 * SLOT;
constexpr size_t WS_ON = WS_T0, WS_MC = WS_S0 + 4 * SLOT;
constexpr size_t WS_VB = WS_S0 + 5 * SLOT;
constexpr size_t WS_HID = WS_S0, WS_Y = WS_S0 + 2 * SLOT;
static_assert((size_t)MAXROWS * DE * 2 <= 2 * SLOT && (size_t)MAXROWS * D * 2 <= 4 * SLOT, "MoE buffers");
constexpr int CW_TMO = 0, CW_CODE = 1, CW_BAR = 4096, CW_CNT = 8192;
constexpr int RING_OFF = 0, RING_BYTES = 131072;
constexpr int TB_OFF = 141312;
constexpr int RW_BYTES = 36 * 1024 * 4;
constexpr int MISC_OFF = 151552, LDS_BYTES = 155648;
static_assert(RW_BYTES <= MISC_OFF && TB_OFF + NH * attn_body::TBW * 4 <= MISC_OFF && MISC_OFF + 1024 <= LDS_BYTES && attn_body::LDS_VOTE == MISC_OFF + 1024 && attn_body::LDS_VOTE + 32 <= LDS_BYTES && MISC_OFF + 1088 + (MAXROWS / 256) * 4 <= LDS_BYTES, "LDS map");

#define GAS __attribute__((address_space(1)))
#define LAS __attribute__((address_space(3)))
typedef unsigned short bf16;
typedef unsigned v4u __attribute__((ext_vector_type(4)));
typedef unsigned v2u __attribute__((ext_vector_type(2)));
typedef int v4i __attribute__((ext_vector_type(4)));
typedef float f32x4 __attribute__((ext_vector_type(4)));
typedef float f32x2v __attribute__((ext_vector_type(2)));
typedef GAS unsigned gu32;
#define RLX_AGENT __ATOMIC_RELAXED, __HIP_MEMORY_SCOPE_AGENT
#define LDS_WAIT() asm volatile("s_waitcnt lgkmcnt(0)" ::: "memory")
#define VM_WAIT() asm volatile("s_waitcnt vmcnt(0)" ::: "memory")
__device__ __forceinline__ unsigned f2bf(float f) { unsigned u = __builtin_bit_cast(unsigned, f); return (u + 0x7fffu + ((u >> 16) & 1u)) >> 16; }
__device__ __forceinline__ unsigned pk2(float lo, float hi) { return f2bf(lo) | (f2bf(hi) << 16); }
__device__ __forceinline__ float bflo(unsigned w) { return __uint_as_float(w << 16); }
__device__ __forceinline__ float bfhi(unsigned w) { return __uint_as_float(w & 0xffff0000u); }

#define XB_TMO      128
#define XB_XCNT(j)  (256  + 64 * (j))
#define XB_XSUB(j)  (1280 + 64 * (j))
#define XB_XGEN(j)  (2304 + 64 * (j))
#define XB_TOP      3328
#define XB_TOPGEN   3392
#define XCD_BAR_WORDS 3456
#define XB_SPIN_CAP (1u << 18)

__device__ __forceinline__ unsigned xb_ld(unsigned* p)              { return __hip_atomic_load(p, __ATOMIC_RELAXED, __HIP_MEMORY_SCOPE_AGENT); }
__device__ __forceinline__ unsigned xb_add(unsigned* p, unsigned v) { return __hip_atomic_fetch_add(p, v, __ATOMIC_RELAXED, __HIP_MEMORY_SCOPE_AGENT); }
__device__ __forceinline__ unsigned xb_xcc_id() { return (unsigned)__builtin_amdgcn_s_getreg((3 << 11) | 20) & 0xFu; }
#define XB_SPIN(cond, bar) do { unsigned _sp = 0; while (cond) { __builtin_amdgcn_s_sleep(1); \
    if ((++_sp & 255u) == 0u) { if (xb_ld(&(bar)[XB_TMO])) break; if (_sp > XB_SPIN_CAP) { atomicAdd(&(bar)[XB_TMO], 1u); break; } } } } while (0)

struct XcdBarrier {
    unsigned* bar; unsigned x;
    volatile LAS unsigned* st;
};

__device__ __forceinline__ XcdBarrier xcd_barrier_post(unsigned* bar, volatile LAS unsigned* st) {
    XcdBarrier b; b.bar = bar; b.x = xb_xcc_id(); b.st = st;
    if (threadIdx.x == 0) (void)xb_add(&bar[XB_XCNT(b.x)], 1u);
    return b;
}
__device__ __forceinline__ void xcd_barrier_complete(unsigned* bar, unsigned x, unsigned& nloc, unsigned& nx) {
    const unsigned G = gridDim.x * gridDim.y * gridDim.z;
    unsigned sum, cnt, mine, sp = 0u;
    for (;;) {
        sum = 0u; cnt = 0u; mine = 0u;
#pragma unroll
        for (unsigned j = 0; j < 16; ++j) { const unsigned c = xb_ld(&bar[XB_XCNT(j)]); sum += c; cnt += (c > 0u) ? 1u : 0u; mine = (j == x) ? c : mine; }
        if (sum == G) break;
        __builtin_amdgcn_s_sleep(1);
        if ((++sp & 255u) == 0u) { if (xb_ld(&bar[XB_TMO])) break; if (sp > XB_SPIN_CAP) { atomicAdd(&bar[XB_TMO], 1u); break; } }
    }
    nloc = mine > 0u ? mine : 1u; nx = cnt > 0u ? cnt : 1u;
}

__device__ __forceinline__ void xcd_barrier(const XcdBarrier& b) {
    asm volatile("s_waitcnt vmcnt(0)" ::: "memory");
    __syncthreads();
    if (threadIdx.x == 0) {
        unsigned* bar = b.bar;
        __builtin_amdgcn_s_waitcnt(0);
        unsigned nloc = b.st[0], nx = b.st[1];
        if (nloc == 0u) { xcd_barrier_complete(bar, b.x, nloc, nx); b.st[0] = nloc; b.st[1] = nx; }
        const unsigned old = xb_add(&bar[XB_XSUB(b.x)], 1u);
        const unsigned gen = old / nloc;
        if (old + 1u == (gen + 1u) * nloc) {
            __builtin_amdgcn_fence(__ATOMIC_RELEASE, "agent");
            asm volatile("s_waitcnt vmcnt(0)" ::: "memory");
            const unsigned og = xb_add(&bar[XB_TOP], 1u);
            const unsigned tg = og / nx;
            if (og + 1u == (tg + 1u) * nx) xb_add(&bar[XB_TOPGEN], 1u);
            else XB_SPIN(xb_ld(&bar[XB_TOPGEN]) == tg, bar);
            __builtin_amdgcn_fence(__ATOMIC_ACQUIRE, "agent");
            xb_add(&bar[XB_XGEN(b.x)], 1u);
            asm volatile("s_waitcnt vmcnt(0)" ::: "memory");
        } else {
            XB_SPIN(xb_ld(&bar[XB_XGEN(b.x)]) == gen, bar);
            __builtin_amdgcn_fence(__ATOMIC_ACQUIRE, "agent");
            asm volatile("s_waitcnt vmcnt(0)" ::: "memory");
        }
    }
    __syncthreads();
}

__device__ __forceinline__ float shx(float v, int o, int lane) { return __int_as_float(__builtin_amdgcn_ds_bpermute((lane ^ o) << 2, __float_as_int(v))); }
__device__ __forceinline__ float shi(float v, int idx) { return __int_as_float(__builtin_amdgcn_ds_bpermute(idx << 2, __float_as_int(v))); }
template <int CTRL> __device__ __forceinline__ float dppf(float v) { return __int_as_float(__builtin_amdgcn_update_dpp(0, __float_as_int(v), CTRL, 0xF, 0xF, true)); }
__device__ __forceinline__ float wave_sum(float v, int) {
    v += dppf<0xB1>(v); v += dppf<0x4E>(v); v += dppf<0x141>(v); v += dppf<0x140>(v);
    { auto r = __builtin_amdgcn_permlane16_swap(__float_as_uint(v), __float_as_uint(v), false, false); v = __uint_as_float(r[0]) + __uint_as_float(r[1]); }
    { auto r = __builtin_amdgcn_permlane32_swap(__float_as_uint(v), __float_as_uint(v), false, false); v = __uint_as_float(r[0]) + __uint_as_float(r[1]); }
    return v;
}
__device__ __forceinline__ void transpose_item(const float* Wsrc, int ldw, bf16* dst, int ldd, LAS float* scr, int lane) {
    float t[64];
#pragma unroll
    for (int i = 0; i < 64; ++i) t[i] = __builtin_nontemporal_load(&Wsrc[(size_t)i * ldw + lane]);
#pragma unroll
    for (int i = 0; i < 64; ++i) scr[i * 65 + lane] = t[i];
    LDS_WAIT(); asm volatile("" ::: "memory");
    const int c = lane & 7;
#pragma unroll
    for (int j = 0; j < 8; ++j) { const int n = (lane >> 3) + 8 * j; const LAS float* s = scr + (8 * c) * 65 + n;
        v4u o; o.x = pk2(s[0 * 65], s[1 * 65]); o.y = pk2(s[2 * 65], s[3 * 65]); o.z = pk2(s[4 * 65], s[5 * 65]); o.w = pk2(s[6 * 65], s[7 * 65]);
        ST16_WT(dst + (size_t)n * ldd + 8 * c, o); }
    LDS_WAIT(); asm volatile("" ::: "memory");
}
__device__ __forceinline__ void transpose_item8(const float* Wsrc, int ldw, unsigned char* dst, int ldd, LAS float* scr, int lane) {
    float t[64];
#pragma unroll
    for (int i = 0; i < 64; ++i) t[i] = __builtin_nontemporal_load(&Wsrc[(size_t)i * ldw + lane]);
#pragma unroll
    for (int i = 0; i < 64; ++i) scr[i * 65 + lane] = t[i];
    LDS_WAIT(); asm volatile("" ::: "memory");
    const int c = lane & 3;
#pragma unroll
    for (int j = 0; j < 4; ++j) { const int n = (lane >> 2) + 16 * j; const LAS float* s = scr + (16 * c) * 65 + n; v4u o;
#pragma unroll
        for (int d = 0; d < 4; ++d) { int w = 0;
            w = __builtin_amdgcn_cvt_pk_fp8_f32(s[(4 * d) * 65] * 32.f, s[(4 * d + 1) * 65] * 32.f, w, false); w = __builtin_amdgcn_cvt_pk_fp8_f32(s[(4 * d + 2) * 65] * 32.f, s[(4 * d + 3) * 65] * 32.f, w, true); o[d] = (unsigned)w; }
        ST16_WT(dst + (size_t)n * ldd + 16 * c, o); }
    LDS_WAIT(); asm volatile("" ::: "memory");
}
constexpr int TSCR_BYTES = 64 * 65 * 4;
struct Ptrs {
    const float* in[23]; float* out; unsigned char* ws;
};

__device__ __forceinline__ const void* ld_arg(int i) { asm volatile("" : "+s"(i)); return ((const void* const*)__builtin_amdgcn_kernarg_segment_ptr())[i]; }
#define ARG(i) ((const float*)ld_arg(i))
#define ARG_OUT ((float*)ld_arg(23))
#define ARG_WS ((unsigned char*)ld_arg(24))
__device__ __forceinline__ void convert_weights(int l, LAS float* scr, int gw, int NGW, int lane) {
    const float* w_in = ARG(4) + (size_t)l * D * IN_COLS; const float* w_ap = ARG(8) + (size_t)l * D * D; const float* w_cp = ARG(10) + (size_t)l * D * D; const float* w_out = ARG(11) + (size_t)l * D * D;
    const float* w1 = ARG(18) + (size_t)l * NE * D * DE; const float* w3 = ARG(19) + (size_t)l * NE * D * DE; const float* w2 = ARG(20) + (size_t)l * NE * DE * D;
    bf16* WIN = (bf16*)(ARG_WS + WS_WIN); bf16* WAC = (bf16*)(ARG_WS + WS_WAC); bf16* WOUT2 = (bf16*)(ARG_WS + WS_WOUT2); bf16* W13 = (bf16*)(ARG_WS + WS_W13); bf16* W2 = (bf16*)(ARG_WS + WS_W2);
    constexpr int I_IN = 16 * 128, I_SQ = 16 * 16, I_E13 = 16 * 8, I_E2 = 8 * 16;
    constexpr int NITEMS = I_IN + 3 * I_SQ + NE * (2 * I_E13 + I_E2);
    for (int it = gw; it < NITEMS; it += NGW) {
        int r = it;
        if (r < I_IN) { const int kb = r / 128, nb = r % 128, n0 = nb * 64, k0 = kb * 64; int dr = n0;
            if (n0 >= 4096 && n0 < 5120) { const int c = n0 - 4096; dr = 4096 + (c / 128) * 256 + (c % 128); }
            else if (n0 >= 5120 && n0 < 6144) { const int c = n0 - 5120; dr = 4096 + (c / 128) * 256 + 128 + (c % 128); }
            if (dr < 3072) transpose_item8(w_in + (size_t)k0 * IN_COLS + n0, IN_COLS, (unsigned char*)WIN + (size_t)dr * D + k0, D, scr, lane);
            else if (dr >= 6144) transpose_item8(w_in + (size_t)k0 * IN_COLS + n0, IN_COLS, (unsigned char*)WIN + (size_t)6144 * D * 2 + (size_t)(dr - 6144) * D + k0, D, scr, lane);
            else transpose_item(w_in + (size_t)k0 * IN_COLS + n0, IN_COLS, WIN + (size_t)dr * D + k0, D, scr, lane);
            continue; } r -= I_IN;
        if (r < I_SQ) { const int kb = r / 16, nb = r % 16; transpose_item(w_ap + (size_t)kb * 64 * D + nb * 64, D, WAC + (size_t)(nb * 64) * D + kb * 64, D, scr, lane); continue; } r -= I_SQ;
        if (r < I_SQ) { const int kb = r / 16, nb = r % 16; transpose_item(w_cp + (size_t)kb * 64 * D + nb * 64, D, WAC + (size_t)(D + nb * 64) * D + kb * 64, D, scr, lane); continue; } r -= I_SQ;
        if (r < I_SQ) { const int kb = r / 16, nb = r % 16; transpose_item(w_out + (size_t)kb * 64 * D + nb * 64, D, WOUT2 + (size_t)(nb * 64) * D + kb * 64, D, scr, lane); continue; } r -= I_SQ;
        const int e = r / (2 * I_E13 + I_E2); r -= e * (2 * I_E13 + I_E2);
        if (r < 2 * I_E13) { const int which = r / I_E13; r -= which * I_E13; const int kb = r / 8, nb = r % 8, n0 = nb * 64;
            const float* src = (which ? w3 : w1) + (size_t)e * D * DE + (size_t)kb * 64 * DE + n0; const int dr = (n0 / 128) * 256 + which * 128 + (n0 % 128);
            transpose_item8(src, DE, (unsigned char*)W13 + ((size_t)e * D + dr) * D + kb * 64, D, scr, lane); continue; } r -= 2 * I_E13;
        { const int kb = r / 16, nb = r % 16; transpose_item8(w2 + (size_t)e * DE * D + (size_t)kb * 64 * D + nb * 64, D, (unsigned char*)W2 + ((size_t)e * D + nb * 64) * DE + kb * 64, DE, scr, lane); }
    }
}
__device__ __forceinline__ int rcol(int j, int lane) { return (j >> 1) * 512 + 8 * lane + (j & 1) * 4; }
__device__ __forceinline__ void load_row_bf16(const bf16* row, f32x4 (&v)[4], int lane) {
    const v4u a = *(const v4u*)(row + 8 * lane), b = *(const v4u*)(row + 512 + 8 * lane);
    v[0] = (f32x4){bflo(a.x), bfhi(a.x), bflo(a.y), bfhi(a.y)}; v[1] = (f32x4){bflo(a.z), bfhi(a.z), bflo(a.w), bfhi(a.w)};
    v[2] = (f32x4){bflo(b.x), bfhi(b.x), bflo(b.y), bfhi(b.y)}; v[3] = (f32x4){bflo(b.z), bfhi(b.z), bflo(b.w), bfhi(b.w)};
}
__device__ __forceinline__ void load_row_fp8(const unsigned char* row, f32x4 (&v)[4], int lane) {
    typedef unsigned u2_ __attribute__((ext_vector_type(2))); typedef float f2_ __attribute__((ext_vector_type(2)));
    const u2_ a = *(const u2_*)(row + 8 * lane), b = *(const u2_*)(row + 512 + 8 * lane);
    { const f2_ p = __builtin_amdgcn_cvt_pk_f32_fp8((int)a.x, false), q = __builtin_amdgcn_cvt_pk_f32_fp8((int)a.x, true); v[0] = (f32x4){p.x, p.y, q.x, q.y}; }
    { const f2_ p = __builtin_amdgcn_cvt_pk_f32_fp8((int)a.y, false), q = __builtin_amdgcn_cvt_pk_f32_fp8((int)a.y, true); v[1] = (f32x4){p.x, p.y, q.x, q.y}; }
    { const f2_ p = __builtin_amdgcn_cvt_pk_f32_fp8((int)b.x, false), q = __builtin_amdgcn_cvt_pk_f32_fp8((int)b.x, true); v[2] = (f32x4){p.x, p.y, q.x, q.y}; }
    { const f2_ p = __builtin_amdgcn_cvt_pk_f32_fp8((int)b.y, false), q = __builtin_amdgcn_cvt_pk_f32_fp8((int)b.y, true); v[3] = (f32x4){p.x, p.y, q.x, q.y}; }
}
__device__ __forceinline__ void load_row_f32(const float* row, f32x4 (&v)[4], int lane) {
#pragma unroll
    for (int j = 0; j < 4; ++j) v[j] = __builtin_nontemporal_load((const f32x4*)(row + rcol(j, lane)));
}
__device__ __forceinline__ void store_row_bf16(bf16* row, const f32x4 (&v)[4], int lane) {
    v4u a, b; a.x = pk2(v[0].x, v[0].y); a.y = pk2(v[0].z, v[0].w); a.z = pk2(v[1].x, v[1].y); a.w = pk2(v[1].z, v[1].w);
    b.x = pk2(v[2].x, v[2].y); b.y = pk2(v[2].z, v[2].w); b.z = pk2(v[3].x, v[3].y); b.w = pk2(v[3].z, v[3].w);
    ST16_WT(row + 8 * lane, a); ST16_WT(row + 512 + 8 * lane, b);
}
__device__ __forceinline__ void store_row_fp8(unsigned char* row, const f32x4 (&v)[4], int lane) {
    typedef unsigned u2_ __attribute__((ext_vector_type(2)));
    int a0 = 0, a1 = 0, b0 = 0, b1 = 0;
    a0 = __builtin_amdgcn_cvt_pk_fp8_f32(v[0].x, v[0].y, a0, false); a0 = __builtin_amdgcn_cvt_pk_fp8_f32(v[0].z, v[0].w, a0, true);
    a1 = __builtin_amdgcn_cvt_pk_fp8_f32(v[1].x, v[1].y, a1, false); a1 = __builtin_amdgcn_cvt_pk_fp8_f32(v[1].z, v[1].w, a1, true);
    b0 = __builtin_amdgcn_cvt_pk_fp8_f32(v[2].x, v[2].y, b0, false); b0 = __builtin_amdgcn_cvt_pk_fp8_f32(v[2].z, v[2].w, b0, true);
    b1 = __builtin_amdgcn_cvt_pk_fp8_f32(v[3].x, v[3].y, b1, false); b1 = __builtin_amdgcn_cvt_pk_fp8_f32(v[3].z, v[3].w, b1, true);
    const u2_ a = {(unsigned)a0, (unsigned)a1}, b = {(unsigned)b0, (unsigned)b1};
    ST8_WT(row + 8 * lane, a); ST8_WT(row + 512 + 8 * lane, b);
}
__device__ __forceinline__ void store_row_f32(float* row, const f32x4 (&v)[4], int lane) {
#pragma unroll
    for (int j = 0; j < 4; ++j) __builtin_nontemporal_store(v[j], (f32x4*)(row + rcol(j, lane)));
}
__device__ __forceinline__ void ln16(f32x4 (&v)[4], const float* g, const float* b, int lane) {
    float s = 0.f;
#pragma unroll
    for (int j = 0; j < 4; ++j) s += (v[j].x + v[j].y) + (v[j].z + v[j].w);
    const float mean = wave_sum(s, lane) * (1.f / D); float s2 = 0.f;
#pragma unroll
    for (int j = 0; j < 4; ++j) { v[j] = v[j] - mean; s2 += (v[j].x * v[j].x + v[j].y * v[j].y) + (v[j].z * v[j].z + v[j].w * v[j].w); }
    const float rstd = 1.f / sqrtf(wave_sum(s2, lane) * (1.f / D) + LN_EPS);
#pragma unroll
    for (int j = 0; j < 4; ++j) { const f32x4 gv = *(const f32x4*)(g + rcol(j, lane)), bv = *(const f32x4*)(b + rcol(j, lane)); v[j] = v[j] * rstd * gv + bv; }
}
__device__ __forceinline__ int t5_bucket(int n) {
    if (n < 16) return n;
    const float nf = (float)n; int large = 16 + (int)(logf(nf / 16.0f) / 2.0794415416798357f * 16.0f);
    return large < 31 ? large : 31;
}

#define PHASE_PTRS unsigned char* ws = ARG_WS; float* out = ARG_OUT; bf16* HB = (bf16*)(ws + WS_HB); int* rowtok = (int*)(ws + WS_ROWTOK); v4i* tokinfo = (v4i*)(ws + WS_TOKINFO); gu32* ctl = (gu32*)(ws + WS_CTL); \
    (void)out; (void)HB; (void)rowtok; (void)tokinfo; (void)ctl; \
    int tidp_ = tid; asm volatile("" : "+v"(tidp_)); const int tidl = tidp_, lanel = tidp_ & 63; (void)tidl; (void)lanel
__device__ __forceinline__ int launder_i(int v) { asm volatile("" : "+s"(v)); return v; }
__global__ void __launch_bounds__(NWAVES * 64, 2) hybrid_fwd(Ptrs P) {
    extern __shared__ __attribute__((aligned(16))) unsigned char lds[];
    LAS unsigned char* L = (LAS unsigned char*)lds;
    volatile LAS unsigned* MISC = (volatile LAS unsigned*)(L + MISC_OFF);
    LAS int* TP = (LAS int*)(L + MISC_OFF + 128);
    LAS int* CN = (LAS int*)(L + MISC_OFF + 128 + 256);
    LAS int* TT = (LAS int*)(L + MISC_OFF + 1088);
    const int tid = threadIdx.x, lane = tid & 63, wave = __builtin_amdgcn_readfirstlane(tid >> 6);
    const int G = gridDim.x; int vcu; { const int bx = blockIdx.x; vcu = (G % 8 == 0) ? (bx % 8) * (G / 8) + bx / 8 : bx; }
    const int gw = vcu * NWAVES + wave, NGW = G * NWAVES;
    unsigned char* ws = ARG_WS;
    gu32* ctl = (gu32*)(ws + WS_CTL);
    for (int u = tid; u < (LDS_BYTES - MISC_OFF) / 4; u += NWAVES * 64) ((LAS unsigned*)(L + MISC_OFF))[u] = 0u;
    __syncthreads();
    XcdBarrier bar = xcd_barrier_post((unsigned*)(ctl + CW_BAR), MISC + 8);
#define GRID_BAR() do { XcdBarrier b_ = bar; asm volatile("" : "+s"(b_.x), "+s"(b_.bar)); xcd_barrier(b_); } while (0)

    float* out = ARG_OUT;
    bf16* HB = (bf16*)(ws + WS_HB);
    int* rowtok = (int*)(ws + WS_ROWTOK); v4i* tokinfo = (v4i*)(ws + WS_TOKINFO);

    if constexpr ((PHASES >> 0) & 1) _Pragma("unroll 1") for (int rep_ = 0, nrep_ = launder_i(1 + ((REPEAT >> 0) & 1)); rep_ < nrep_; ++rep_) {
        LAS float* scr = (LAS float*)(L + RING_OFF + wave * TSCR_BYTES);
        convert_weights(0, scr, gw, NGW, lane);
        const float* x = ARG(0);
        { float* img = (float*)(ws + WS_RIMG); const float* wrg = ARG(14); const float* wre = ARG(16);
#define WLIDX(o, k) ((((o) * 4 + (((k) >> 9) * 2 + (((k) & 7) >> 2))) * 64 + (((k) & 511) >> 3)) * 4 + ((k) & 3))
          for (int i = (int)blockIdx.x * (NWAVES * 64) + tid; i < DEPTH * 36 * D; i += G * NWAVES * 64) { const int ll = i / (36 * D), r = i - ll * (36 * D), o = r >> 10, k = r & (D - 1);
              img[ll * 36 * D + WLIDX(o, k)] = (o < 4) ? wrg[(size_t)ll * D * 4 + k * 4 + o] : wre[(size_t)ll * D * NE + k * NE + (o - 4)]; }
#undef WLIDX
        }
        { const float* g0 = ARG(1); const float* b0 = ARG(2);
        for (int m = gw; m < M; m += 4 * NGW) { f32x4 v[4], w[4], x2[4], x3[4];
            load_row_f32(x + (size_t)m * D, v, lane); load_row_f32(x + (size_t)(m + NGW) * D, w, lane); load_row_f32(x + (size_t)(m + 2 * NGW) * D, x2, lane); load_row_f32(x + (size_t)(m + 3 * NGW) * D, x3, lane);
            ln16(v, g0, b0, lane); ln16(w, g0, b0, lane); ln16(x2, g0, b0, lane); ln16(x3, g0, b0, lane);
            store_row_bf16(HB + (size_t)m * D, v, lane); store_row_bf16(HB + (size_t)(m + NGW) * D, w, lane); store_row_bf16(HB + (size_t)(m + 2 * NGW) * D, x2, lane); store_row_bf16(HB + (size_t)(m + 3 * NGW) * D, x3, lane);
            { unsigned char* h8 = ws + WS_HB8;
              store_row_fp8(h8 + (size_t)m * D, v, lane); store_row_fp8(h8 + (size_t)(m + NGW) * D, w, lane); store_row_fp8(h8 + (size_t)(m + 2 * NGW) * D, x2, lane); store_row_fp8(h8 + (size_t)(m + 3 * NGW) * D, x3, lane); } } }
        GRID_BAR();
    }

#pragma unroll 1
    for (int l = 0; l < DEPTH; ++l) {
        const float lam_init = __int_as_float(launder_i((l == 0) ? 0x3e4ccccd : 0x3eb60549));
        int Gl = G, vcul = vcu, bxl = (int)blockIdx.x; asm volatile("" : "+s"(Gl), "+s"(vcul), "+s"(bxl));
        int tidl = tid; asm volatile("" : "+v"(tidl)); const int lanel = tidl & 63; const int gwl = vcul * NWAVES + wave, NGWl = Gl * NWAVES;
        if constexpr ((PHASES >> 1) & 1) _Pragma("unroll 1") for (int rep_ = 0, nrep_ = launder_i(1 + ((REPEAT >> 1) & 1)); rep_ < nrep_; ++rep_) {
            PHASE_PTRS;
            pg8::ProbDense8<512> pr{(const bf16*)(ws + WS_HB8), (const bf16*)(ws + WS_WIN)}; pg8::StaticOrder S; S.init(M, 3072, Gl, bxl);
            pg8::EpiQKV E{(bf16*)(ws + WS_Q), SLOT / 2, attn_body::C2};
            pg8::gemm_phase<pg8::EpiQKV, pg8::ProbDense8<512>, pg8::StaticOrder>(L + RING_OFF, pr, S, E);
            GRID_BAR();
        }
        if constexpr ((PHASES >> 2) & 1) _Pragma("unroll 1") for (int rep_ = 0, nrep_ = launder_i(1 + ((REPEAT >> 2) & 1)); rep_ < nrep_; ++rep_) {
            PHASE_PTRS;
            LAS float* tb = (LAS float*)(L + TB_OFF); const float* rel = ARG(3);
            { constexpr int NT_ = NH * attn_body::TBW / (NWAVES * 64); static_assert(NT_ * NWAVES * 64 == NH * attn_body::TBW, "bias table"); float va[NT_], vb[NT_];
              _Pragma("unroll") for (int k_ = 0; k_ < NT_; ++k_) { const int i = tidl + k_ * NWAVES * 64, h = i / attn_body::TBW, d = i - h * attn_body::TBW - attn_body::TBP, dd = (d >= 0 && d < 128) ? d : 0;
                  va[k_] = rel[t5_bucket(dd) * NH + h]; vb[k_] = rel[31 * NH + h]; }
              _Pragma("unroll") for (int k_ = 0; k_ < NT_; ++k_) { const int i = tidl + k_ * NWAVES * 64, h = i / attn_body::TBW, d = i - h * attn_body::TBW - attn_body::TBP;
                  tb[i] = d < 0 ? -INFINITY : d < 128 ? (va[k_] - vb[k_]) * LOG2E : 0.f; } }
            __syncthreads();
            const float* lv = ARG(6) + (size_t)l * 4 * 64;
            const float lam = __int_as_float(__builtin_amdgcn_readfirstlane(__float_as_int(expf(wave_sum(lv[lanel] * lv[64 + lanel], lanel)) - expf(wave_sum(lv[128 + lanel] * lv[192 + lanel], lanel)) + lam_init)));
            const attn_body::AttnTensors AT{(const attn_body::bf16*)(ws + WS_Q), (const attn_body::bf16*)(ws + WS_K), (const attn_body::bf16*)(ws + WS_V), (attn_body::bf16*)(ws + WS_ON), lam, __int_as_float(launder_i((l == 0) ? 0x3f4ccccd : 0x3f24fd5c))  , ARG(7) + (size_t)l * VD};
            const attn_body::StaticOrder S(Gl, vcul);
#if ATTN_PROBE_VAR
            if (rep_ > 0) { attn_body::AttnTensors AT2 = AT; AT2.O = (attn_body::bf16*)(ws + WS_S0 + 4 * SLOT);
                attn_body::attn_phase<attn_body::StaticOrder, ATTN_PROBE_VAR>((char*)lds + RING_OFF, AT2, S, (attn_body::lds_cfptr)tb); }
            else
#endif
            attn_body::attn_phase<attn_body::StaticOrder>((char*)lds + RING_OFF, AT, S, (attn_body::lds_cfptr)tb);
            GRID_BAR();
        }
        if constexpr ((PHASES >> 3) & 1) _Pragma("unroll 1") for (int rep_ = 0, nrep_ = launder_i(1 + ((REPEAT >> 3) & 1)); rep_ < nrep_; ++rep_) {
            PHASE_PTRS;
            pg8::EpiConvGate E{(bf16*)(ws + WS_CB), (bf16*)(ws + WS_PB), (unsigned char*)(ws + WS_GB), ARG(5) + (size_t)l * 2 * D};
            { pg8::ProbDense<1024> pr{HB, (const bf16*)(ws + WS_WIN) + (size_t)3072 * D}; pg8::StaticOrder S; S.init(M, 3072, Gl, bxl);
              pg8::gemm_phase<pg8::EpiConvGate, pg8::ProbDense<1024>, pg8::StaticOrder>(L + RING_OFF, pr, S, E); }
            { pg8::ProbDense8<512> pr{(const bf16*)(ws + WS_HB8), (const bf16*)(ws + WS_WIN) + (size_t)6144 * D}; pg8::StaticOrder S; S.init(M, 2048, Gl, bxl);
              pg8::EpiGateOnly E2{E};
              pg8::gemm_phase<pg8::EpiGateOnly, pg8::ProbDense8<512>, pg8::StaticOrder>(L + RING_OFF, pr, S, E2); }
            GRID_BAR();
        }
        if constexpr ((PHASES >> 4) & 1) _Pragma("unroll 1") for (int rep_ = 0, nrep_ = launder_i(1 + ((REPEAT >> 4) & 1)); rep_ < nrep_; ++rep_) {
            PHASE_PTRS;
            const bf16* PB = (const bf16*)(ws + WS_PB); bf16* CB = (bf16*)(ws + WS_CB);
            const float* cw = ARG(9) + (size_t)l * 3 * D;
            float w[2][3][8];
#pragma unroll
            for (int c = 0; c < 2; ++c)
#pragma unroll
                for (int j = 0; j < 3; ++j)
#pragma unroll
                    for (int i = 0; i < 8; ++i) w[c][j][i] = cw[j * D + c * 512 + 8 * lanel + i];
            bf16* UD = rep_ ? (bf16*)(ws + WS_T1) : CB;
            for (int blk = gwl; blk < M / 16; blk += NGWl) { const int row0 = blk * 16; const bool head = (row0 & (SEQ - 1)) == 0;
#pragma unroll
                for (int c = 0; c < 2; ++c) { const size_t off0 = (size_t)row0 * D + c * 512 + 8 * lanel;
                    v4u q[6]; q[0] = (v4u){0u, 0u, 0u, 0u}; q[1] = (v4u){0u, 0u, 0u, 0u};
                    if (!head) { q[0] = *(const v4u*)(PB + off0 - 2 * D); q[1] = *(const v4u*)(PB + off0 - D); }
#pragma unroll
                    for (int i = 0; i < 16; i += 4) { v4u cbv[4];
#pragma unroll
                        for (int j = 0; j < 4; ++j) { q[2 + j] = *(const v4u*)(PB + off0 + (size_t)(i + j) * D); cbv[j] = *(const v4u*)(CB + off0 + (size_t)(i + j) * D); }
#pragma unroll
                        for (int j = 0; j < 4; ++j) { v4u o;
#pragma unroll
                            for (int e = 0; e < 4; ++e) {
                                const float lo = bflo(cbv[j][e]) * (w[c][0][2 * e] * bflo(q[j][e]) + w[c][1][2 * e] * bflo(q[j + 1][e]) + w[c][2][2 * e] * bflo(q[j + 2][e]));
                                const float hi = bfhi(cbv[j][e]) * (w[c][0][2 * e + 1] * bfhi(q[j][e]) + w[c][1][2 * e + 1] * bfhi(q[j + 1][e]) + w[c][2][2 * e + 1] * bfhi(q[j + 2][e]));
                                o[e] = pk2(lo, hi); }
                            ST16_WT(UD + off0 + (size_t)(i + j) * D, o); }
                        q[0] = q[4]; q[1] = q[5]; } } }
            GRID_BAR();
        }
        if constexpr ((PHASES >> 5) & 1) _Pragma("unroll 1") for (int rep_ = 0, nrep_ = launder_i(1 + ((REPEAT >> 5) & 1)); rep_ < nrep_; ++rep_) {
            PHASE_PTRS;
            pg8::ProbDual<1024> pr{(const bf16*)(ws + WS_ON), (const bf16*)(ws + WS_CB), (const bf16*)(ws + WS_WAC)}; pg8::DualOrder S; S.S.init(M, 1024, Gl, bxl);
            pg8::EpiDual E{(bf16*)(ws + WS_MC), (const unsigned char*)(ws + WS_GB)};
            pg8::gemm_phase<pg8::EpiDual, pg8::ProbDual<1024>, pg8::DualOrder>(L + RING_OFF, pr, S, E);
            GRID_BAR();
        }
        if constexpr ((PHASES >> 6) & 1) _Pragma("unroll 1") for (int rep_ = 0, nrep_ = launder_i(1 + ((REPEAT >> 6) & 1)); rep_ < nrep_; ++rep_) {
            PHASE_PTRS;
            pg8::ProbDense<1024> pr{(const bf16*)(ws + WS_MC), (const bf16*)(ws + WS_WOUT2)}; pg8::StaticOrder S; S.init(M, 1024, Gl, bxl);
            pg8::EpiResid E{HB, (bf16*)(ws + WS_VB), DN_ALPHA};
            pg8::gemm_phase<pg8::EpiResid, pg8::ProbDense<1024>, pg8::StaticOrder>(L + RING_OFF, pr, S, E);
            GRID_BAR();
        }
        if constexpr ((PHASES >> 7) & 1) _Pragma("unroll 1") for (int rep_ = 0, nrep_ = launder_i(1 + ((REPEAT >> 7) & 1)); rep_ < nrep_; ++rep_) {
            PHASE_PTRS;
            LAS float* WL = (LAS float*)L;
            { const f32x4* img = (const f32x4*)(ws + WS_RIMG + (size_t)l * RW_BYTES);
              constexpr int NI = RW_BYTES / 16 / (NWAVES * 64); static_assert(NI * NWAVES * 64 * 16 == RW_BYTES, "router image"); f32x4 t[NI];
              _Pragma("unroll") for (int i = 0; i < NI; ++i) t[i] = img[tidl + i * NWAVES * 64];
              _Pragma("unroll") for (int i = 0; i < NI; ++i) ((LAS f32x4*)WL)[tidl + i * NWAVES * 64] = t[i]; }
            __syncthreads();
            const float* brg = ARG(15) + l * 4; const float* bre = ARG(17) + l * NE;
            const float* g1 = ARG(12) + (size_t)l * D; const float* b1 = ARG(13) + (size_t)l * D;
            gu32* cnt = ctl + CW_CNT + l * NE * 64; bf16* hb_dst = HB; int* rt_dst = rowtok; v4i* ti_dst = tokinfo; const bf16* VB = (const bf16*)(ws + WS_VB);
            if (rep_ > 0) { cnt = ctl + CW_CNT + (2 + l) * NE * 64; hb_dst = (bf16*)(ws + WS_S0 + 2 * SLOT); rt_dst = (int*)(ws + WS_S0 + 3 * SLOT); ti_dst = (v4i*)(ws + WS_S0 + 4 * SLOT); }
            int E0 = 0, E1 = 0; float G0 = 0.f, G1 = 0.f; int k = 0;
#define BFLY(v, n, mask) _Pragma("unroll") for (int i_ = 0; i_ < (n); ++i_) { const bool up_ = (lanel & (mask)) != 0; const float send_ = up_ ? v[i_] : v[i_ + (n)], keep_ = up_ ? v[i_ + (n)] : v[i_]; v[i_] = keep_ + XLANE(send_, mask); }
#define XLANE(x_, mask) ((mask) == 32 ? ({ auto r_ = __builtin_amdgcn_permlane32_swap(__float_as_uint(x_), __float_as_uint(x_), false, false); __uint_as_float((lanel & 32) ? r_[0] : r_[1]); }) \
                       : (mask) == 16 ? ({ auto r_ = __builtin_amdgcn_permlane16_swap(__float_as_uint(x_), __float_as_uint(x_), false, false); __uint_as_float((lanel & 16) ? r_[0] : r_[1]); }) \
                       : dppf<0x128>(x_))
#define RDOT(row_, col) ({ f32x2v a_ = {0.f, 0.f}; _Pragma("unroll") for (int j_ = 0; j_ < 4; ++j_) { const f32x4 wv_ = *(const LAS f32x4*)(WL + (((col) * 4 + j_) * 64 + lanel) * 4); \
                a_ = __builtin_elementwise_fma(row_[j_].xy, wv_.xy, a_); a_ = __builtin_elementwise_fma(row_[j_].zw, wv_.zw, a_); } a_.x + a_.y; })
#define ROUTE_TOKEN(row_, kk) do { float pg[4]; \
                _Pragma("unroll") for (int o = 0; o < 4; ++o) pg[o] = RDOT(row_, o); \
                BFLY(pg, 2, 32); BFLY(pg, 1, 16); \
                pg[0] += dppf<0xB1>(pg[0]); pg[0] += dppf<0x4E>(pg[0]); pg[0] += dppf<0x141>(pg[0]); pg[0] += dppf<0x140>(pg[0]);        \
                const float gv = pg[0] + brg[lanel >> 4]; float lg[4];                            \
                _Pragma("unroll") for (int j = 0; j < 4; ++j) lg[j] = __int_as_float(__builtin_amdgcn_readlane(__float_as_int(gv), 16 * j)); \
                int gi = 0; float gm = lg[0]; \
                _Pragma("unroll") for (int j = 1; j < 4; ++j) if (lg[j] > gm) { gm = lg[j]; gi = j; } \
                float gs = 0.f; \
                _Pragma("unroll") for (int j = 0; j < 4; ++j) gs += __builtin_amdgcn_exp2f((lg[j] - gm) * LOG2E); \
                asm volatile("" : "+v"(gs)); \
                const float gp = __builtin_amdgcn_rcpf(gs); \
                const int gis = __builtin_amdgcn_readfirstlane(gi); float pe[8];                    \
                _Pragma("unroll") for (int j = 0; j < 8; ++j) pe[j] = RDOT(row_, 4 + 8 * gis + j); \
                BFLY(pe, 4, 32); BFLY(pe, 2, 16); BFLY(pe, 1, 8); \
                pe[0] += dppf<0xB1>(pe[0]); pe[0] += dppf<0x4E>(pe[0]); pe[0] += dppf<0x141>(pe[0]);                                     \
                const float ev = pe[0] + bre[8 * gis + (lanel >> 3)]; float le[8];                 \
                _Pragma("unroll") for (int j = 0; j < 8; ++j) le[j] = __int_as_float(__builtin_amdgcn_readlane(__float_as_int(ev), 8 * j)); \
                int i1 = 0; float m1 = le[0]; \
                _Pragma("unroll") for (int j = 1; j < 8; ++j) if (le[j] > m1) { m1 = le[j]; i1 = j; } \
                int i2 = -1; float m2 = -INFINITY; \
                _Pragma("unroll") for (int j = 0; j < 8; ++j) if (j != i1 && le[j] > m2) { m2 = le[j]; i2 = j; } \
                const float r = __builtin_amdgcn_exp2f((m2 - m1) * LOG2E), den = __builtin_amdgcn_rcpf(1.f + r); \
                if (lanel == (kk)) { E0 = gis * 8 + i1; E1 = gis * 8 + i2; G0 = gp * den; G1 = gp * r * den; } } while (0)
            for (int m = gwl; m < M; m += 4 * NGWl, k += 4) { f32x4 v[4], w[4], x2[4], x3[4];
                load_row_bf16(VB + (size_t)m * D, v, lanel); load_row_bf16(VB + (size_t)(m + NGWl) * D, w, lanel);
                load_row_bf16(VB + (size_t)(m + 2 * NGWl) * D, x2, lanel); load_row_bf16(VB + (size_t)(m + 3 * NGWl) * D, x3, lanel);
                ln16(v, g1, b1, lanel); ln16(w, g1, b1, lanel); ln16(x2, g1, b1, lanel); ln16(x3, g1, b1, lanel);
                store_row_bf16(hb_dst + (size_t)m * D, v, lanel); store_row_bf16(hb_dst + (size_t)(m + NGWl) * D, w, lanel);
                store_row_bf16(hb_dst + (size_t)(m + 2 * NGWl) * D, x2, lanel); store_row_bf16(hb_dst + (size_t)(m + 3 * NGWl) * D, x3, lanel);
                { unsigned char* h8 = ws + WS_HB8;
                  store_row_fp8(h8 + (size_t)m * D, v, lanel); store_row_fp8(h8 + (size_t)(m + NGWl) * D, w, lanel); store_row_fp8(h8 + (size_t)(m + 2 * NGWl) * D, x2, lanel); store_row_fp8(h8 + (size_t)(m + 3 * NGWl) * D, x3, lanel); }
                ROUTE_TOKEN(v, k); ROUTE_TOKEN(w, k + 1); ROUTE_TOKEN(x2, k + 2); ROUTE_TOKEN(x3, k + 3);
            }
#undef BFLY
#undef XLANE
#undef RDOT
#undef ROUTE_TOKEN
            LAS unsigned* HIST = (LAS unsigned*)(L + MISC_OFF + 512); LAS unsigned* BASE = (LAS unsigned*)(L + MISC_OFF + 640);
            if (tidl < NE) HIST[tidl] = 0u;
            __syncthreads();
            unsigned p0 = 0u, p1 = 0u;
            if (lanel < k) { p0 = __hip_atomic_fetch_add(HIST + E0, 1u, __ATOMIC_RELAXED, __HIP_MEMORY_SCOPE_WORKGROUP); p1 = __hip_atomic_fetch_add(HIST + E1, 1u, __ATOMIC_RELAXED, __HIP_MEMORY_SCOPE_WORKGROUP); }
            __syncthreads();
            if (tidl < NE) { const unsigned c = HIST[tidl]; BASE[tidl] = c ? __hip_atomic_fetch_add(cnt + tidl * 64, c, RLX_AGENT) : 0u; }
            __syncthreads();
            if (lanel < k) { const int tok = gwl + lanel * NGWl;
                p0 += BASE[E0]; p1 += BASE[E1];
                rt_dst[(size_t)E0 * CAP + p0] = tok; rt_dst[(size_t)E1 * CAP + p1] = tok;
                ti_dst[tok] = (v4i){(int)(E0 * CAP + p0), (int)(E1 * CAP + p1), __float_as_int(G0), __float_as_int(G1)}; }
            GRID_BAR();
        }
        {
            PHASE_PTRS;
            gu32* cnt = ctl + CW_CNT + l * NE * 64;
            if (tidl < NE) CN[tidl] = (int)__hip_atomic_load(cnt + tidl * 64, RLX_AGENT);
            __syncthreads();
            if (tidl == 0) { int a = 0; for (int e = 0; e < NE; ++e) { TP[e] = a; a += (CN[e] + 255) >> 8; } TP[NE] = a; }
            if (tidl < NE) { const int e = tidl; int fb = 0, c1b = 0, c2b = 0, F = 0, C1 = 0;
                for (int j = 0; j < NE; ++j) { const int cj = CN[j], fj = cj >> 8, rj = cj & 255, is1 = rj > 128, is2 = (rj > 0 && rj <= 128); F += fj; C1 += is1; if (j < e) { fb += fj; c1b += is1; c2b += is2; } }
                const int cn = CN[e], nf = cn >> 8, r = cn & 255;
                for (int t = 0; t < nf; ++t) TT[fb + t] = (e << 16) | t;
                if (r > 128) TT[F + c1b] = (e << 16) | nf; else if (r > 0) TT[F + C1 + c2b] = (e << 16) | nf; }
            __syncthreads();
        }
        if constexpr ((PHASES >> 8) & 1) _Pragma("unroll 1") for (int rep_ = 0, nrep_ = launder_i(1 + ((REPEAT >> 8) & 1)); rep_ < nrep_; ++rep_) {
            PHASE_PTRS;
            pg8::ProbMoe<512, 4, true, true> pr{(const bf16*)(ws + WS_HB8), (const bf16*)(ws + WS_W13), rowtok, CAP}; pg8::MoeOrder S{TP, CN, TT, 4, Gl, vcul};
            pg8::EpiSilu8 E{ws + WS_HID};
            pg8::gemm_phase<pg8::EpiSilu8, pg8::ProbMoe<512, 4, true, true>, pg8::MoeOrder>(L + RING_OFF, pr, S, E);
            GRID_BAR();
        }
        if constexpr ((PHASES >> 9) & 1) _Pragma("unroll 1") for (int rep_ = 0, nrep_ = launder_i(1 + ((REPEAT >> 9) & 1)); rep_ < nrep_; ++rep_) {
            PHASE_PTRS;
            pg8::ProbMoe<256, 4, false, true> pr{(const bf16*)(ws + WS_HID), (const bf16*)(ws + WS_W2), rowtok, CAP}; pg8::MoeOrder S{TP, CN, TT, 4, Gl, vcul};
            pg8::EpiOut8 E{ws + WS_Y};
            pg8::gemm_phase<pg8::EpiOut8, pg8::ProbMoe<256, 4, false, true>, pg8::MoeOrder>(L + RING_OFF, pr, S, E);
            GRID_BAR();
        }
        if constexpr ((PHASES >> 10) & 1) {
            PHASE_PTRS;
            _Pragma("unroll 1") for (int rep_ = 0, nrep_ = launder_i(1 + ((REPEAT >> 10) & 1)); rep_ < nrep_; ++rep_) {
            const unsigned char* Y = ws + WS_Y;
            const float* g2 = ARG(21) + (size_t)l * D; const float* b2 = ARG(22) + (size_t)l * D;
            bf16* hb_dst = HB;
            if (rep_ > 0) { hb_dst = (bf16*)(ws + WS_S0 + 5 * SLOT); }
#define MOE_ROW(v, m) do { const v4i ti = tokinfo[m]; \
                const int e0 = ti.x >> 15, e1 = ti.y >> 15; const size_t r0 = (size_t)TP[e0] * 256 + (ti.x & (CAP - 1)), r1 = (size_t)TP[e1] * 256 + (ti.y & (CAP - 1)); \
                const float ga = __int_as_float(ti.z), gb = __int_as_float(ti.w); f32x4 y0[4], y1[4]; \
                load_row_bf16(HB + (size_t)(m) * D, v, lanel); load_row_fp8(Y + r0 * D, y0, lanel); load_row_fp8(Y + r1 * D, y1, lanel); \
                _Pragma("unroll") for (int j = 0; j < 4; ++j) v[j] = v[j] * DN_ALPHA + y0[j] * ga + y1[j] * gb; } while (0)
            const bool last_layer = (l + 1 == DEPTH);
            for (int m = gwl; m < M; m += 4 * NGWl) { const int m2 = m + NGWl, m3 = m + 2 * NGWl, m4 = m + 3 * NGWl; f32x4 v[4], w[4], x2[4], x3[4];
                MOE_ROW(v, m); MOE_ROW(w, m2); MOE_ROW(x2, m3); MOE_ROW(x3, m4);
                ln16(v, g2, b2, lanel); ln16(w, g2, b2, lanel); ln16(x2, g2, b2, lanel); ln16(x3, g2, b2, lanel);
                if (last_layer && rep_ == 0) { store_row_f32(out + (size_t)m * D, v, lanel); store_row_f32(out + (size_t)m2 * D, w, lanel); store_row_f32(out + (size_t)m3 * D, x2, lanel); store_row_f32(out + (size_t)m4 * D, x3, lanel); }
                else { store_row_bf16(hb_dst + (size_t)m * D, v, lanel); store_row_bf16(hb_dst + (size_t)m2 * D, w, lanel); store_row_bf16(hb_dst + (size_t)m3 * D, x2, lanel); store_row_bf16(hb_dst + (size_t)m4 * D, x3, lanel);
                    unsigned char* h8 = ws + WS_HB8; store_row_fp8(h8 + (size_t)m * D, v, lanel); store_row_fp8(h8 + (size_t)m2 * D, w, lanel); store_row_fp8(h8 + (size_t)m3 * D, x2, lanel); store_row_fp8(h8 + (size_t)m4 * D, x3, lanel); } }
#undef MOE_ROW
            }
            if (l + 1 < DEPTH) { __syncthreads(); LAS float* scr = (LAS float*)(L + RING_OFF + wave * TSCR_BYTES);
                _Pragma("unroll 1") for (int rep_ = 0, nrep_ = launder_i(1 + ((REPEAT >> 11) & 1)); rep_ < nrep_; ++rep_) convert_weights(l + 1, scr, gwl, NGWl, lanel);
                GRID_BAR(); }
        }
    }
}

extern "C" void kernel_launch(void* const* d_in, const int* in_sizes, int n_in, void* d_out, int out_size, void* d_ws, size_t ws_size, hipStream_t stream) {
    static int grid = 0;
    if (grid == 0) {
        if (n_in != 23 || in_sizes[0] != M * D || out_size != M * D || ws_size < WS_END) { fprintf(stderr, "kernel_launch: unexpected shapes (n_in %d, in0 %d, out %d, ws %zu < %zu); nothing launched\n", n_in, n_in > 0 ? in_sizes[0] : -1, out_size, ws_size, (size_t)WS_END); grid = -1; return; }
        int dev = 0, cus = 0, per_cu = 0;
        if (hipGetDevice(&dev) != hipSuccess || hipDeviceGetAttribute(&cus, hipDeviceAttributeMultiprocessorCount, dev) != hipSuccess) { fprintf(stderr, "kernel_launch: device query failed\n"); grid = -1; return; }
        if (hipFuncSetAttribute((const void*)hybrid_fwd, hipFuncAttributeMaxDynamicSharedMemorySize, LDS_BYTES) != hipSuccess) { fprintf(stderr, "kernel_launch: hipFuncSetAttribute failed\n"); grid = -1; return; }
        if (hipOccupancyMaxActiveBlocksPerMultiprocessor(&per_cu, (const void*)hybrid_fwd, NWAVES * 64, LDS_BYTES) != hipSuccess || per_cu < 1) { fprintf(stderr, "kernel_launch: occupancy query reports %d workgroups per CU\n", per_cu); }
        (void)hipGetLastError();
        grid = cus;
    }
    if (grid < 0) return;
    if (hipMemsetAsync((char*)d_ws + WS_CTL, 0, CTL_ZERO_BYTES, stream) != hipSuccess) { fprintf(stderr, "kernel_launch: hipMemsetAsync failed\n"); return; }
    Ptrs a{};
    for (int i = 0; i < 23; ++i) a.in[i] = (const float*)d_in[i];
    a.out = (float*)d_out; a.ws = (unsigned char*)d_ws;
    hipLaunchKernelGGL(hybrid_fwd, dim3(grid), dim3(NWAVES * 64), LDS_BYTES, stream, a);
    const hipError_t le = hipPeekAtLastError();
    if (le != hipSuccess) fprintf(stderr, "kernel_launch: launch failed: %s\n", hipGetErrorName(le));
}
```

```cpp
#include <hip/hip_runtime.h>
#include <hip/hip_bf16.h>
#include <cstdio>
#include <cstdint>
#include <cmath>

#define ST8_WT(p_, v_) asm volatile("global_store_dwordx2 %0, %1, off sc1" :: "v"((unsigned long long)(uintptr_t)(p_)), "v"(v_) : "memory")
#define ST16_WT(p_, v_) asm volatile("global_store_dwordx4 %0, %1, off sc1\n\ts_nop 1" :: "v"((unsigned long long)(uintptr_t)(p_)), "v"(v_) : "memory")

namespace pg8 {
#define PG8_LAS __attribute__((address_space(3)))
typedef unsigned short bf16_t;
typedef short bf16x8 __attribute__((ext_vector_type(8)));
typedef float f32x4 __attribute__((ext_vector_type(4)));
typedef float f32x2 __attribute__((ext_vector_type(2)));
typedef unsigned u32x4 __attribute__((ext_vector_type(4)));
typedef unsigned u32x2 __attribute__((ext_vector_type(2)));
typedef int v8i32 __attribute__((ext_vector_type(8)));
constexpr int BM = 256, BK = 64, HALF = 128, HTB = HALF * BK * 2  , STAGE_BYTES = 8 * HTB, NXCD = 8, WGM = 8;

__host__ __device__ __forceinline__ int lds_byte(int r, int c) { const int st = (r >> 4) * 2 + (c >> 5), rr = r & 15, cc = c & 31, ob = rr * 64 + cc * 2; return st * 1024 + (ob ^ (((ob >> 9) & 1) << 5)); }
__host__ __device__ __forceinline__ void stage_rc(int b, int& R, int& C) { const int st = b / 1024, sb = b % 1024, swz = sb ^ (((sb >> 9) & 1) << 5); R = (st >> 1) * 16 + swz / 64; C = (st & 1) * 32 + (swz % 64) / 2; }
__host__ __device__ __forceinline__ int perm32(int rho) { const int n = rho >> 4, i = rho & 15; return 8 * (i >> 2) + 4 * n + (i & 3); }

struct Unit { int pm, pn, e, nv, lrow; };

struct StaticOrder {
    int nM, nN, nwg, G, c;
    __host__ __device__ void init(int M, int N, int G_, int c_) { nM = M / BM; nN = N / BM; nwg = nM * nN; G = G_; c = c_; }
    __host__ __device__ bool next(int i, Unit& u) const {
        const long L = (long)i * G + c; if (L >= nwg) return false;
        int wgid = (int)L; { const int q = nwg / NXCD, r = nwg % NXCD, xcd = wgid % NXCD, off = wgid / NXCD; wgid = (xcd < r ? xcd * (q + 1) : r * (q + 1) + (xcd - r) * q) + off; }
        const int nig = WGM * nN, gid = wgid / nig, fm = gid * WGM, gsz = (nM - fm) < WGM ? (nM - fm) : WGM;
        u.pm = fm + ((wgid % nig) % gsz); u.pn = (wgid % nig) / gsz; u.e = 0; u.nv = BM; u.lrow = 0; return true;
    }
};

typedef __bf16 bf16x2_t __attribute__((ext_vector_type(2)));
__device__ __forceinline__ unsigned cvt_pk_bf16(float lo, float hi) { f32x2 v = {lo, hi}; bf16x2_t b = __builtin_convertvector(v, bf16x2_t); return __builtin_bit_cast(unsigned, b); }
__device__ __forceinline__ float sigmoidf_fast(float x) { return __builtin_amdgcn_rcpf(1.0f + __builtin_amdgcn_exp2f(-1.4426950408889634f * x)); }
__device__ __forceinline__ float bf_lo(unsigned w) { return __uint_as_float(w << 16); }
__device__ __forceinline__ float bf_hi(unsigned w) { return __uint_as_float(w & 0xffff0000u); }

#define PG8_FOR_AM _Pragma("unroll") for (int ai = 0; ai < 2; ++ai) _Pragma("unroll") for (int m = 0; m < 4; ++m)

struct EpiQKV {
    static constexpr bool PERM = true;
    bf16_t* O; size_t stride; float scale0;
    __device__ __forceinline__ void operator()(const f32x4 (&acc)[2][2][4][2], const Unit& u, int wr, int wc, int fr, int fq) const {
        const int t = u.pn >> 2; bf16_t* base = O + (size_t)t * stride; const float sc = (t == 0) ? scale0 : 1.0f;
        const int row0 = u.pm * BM + wr * 64 + fr, col0 = (u.pn & 3) * BM + wc * 32 + 8 * fq;
        PG8_FOR_AM { bf16_t* rowp = base + (size_t)(row0 + ai * HALF + m * 16) * 1024 + col0;
#pragma unroll
            for (int bj = 0; bj < 2; ++bj) { const f32x4 v0 = acc[ai][bj][m][0] * sc, v1 = acc[ai][bj][m][1] * sc; u32x4 w;
                w.x = cvt_pk_bf16(v0[0], v0[1]); w.y = cvt_pk_bf16(v0[2], v0[3]); w.z = cvt_pk_bf16(v1[0], v1[1]); w.w = cvt_pk_bf16(v1[2], v1[3]);
                ST16_WT(rowp + bj * HALF, w); } }
    }
};
struct EpiConvGate {
    static constexpr bool PERM = true;
    bf16_t* CB; bf16_t* PB; unsigned char* GB; const float* gb;
    __device__ __forceinline__ void operator()(const f32x4 (&acc)[2][2][4][2], const Unit& u, int wr, int wc, int fr, int fq) const {
        const int row0 = u.pm * BM + wr * 64 + fr;
        if (u.pn < 4) {
            const int col0 = u.pn * BM + wc * 32 + 8 * fq;
            PG8_FOR_AM { bf16_t* rowp = CB + (size_t)(row0 + ai * HALF + m * 16) * 1024 + col0;
#pragma unroll
                for (int bj = 0; bj < 2; ++bj) { const f32x4 v0 = acc[ai][bj][m][0], v1 = acc[ai][bj][m][1]; u32x4 w;
                    w.x = cvt_pk_bf16(v0[0], v0[1]); w.y = cvt_pk_bf16(v0[2], v0[3]); w.z = cvt_pk_bf16(v1[0], v1[1]); w.w = cvt_pk_bf16(v1[2], v1[3]);
                    ST16_WT(rowp + bj * HALF, w); } }
        } else if (u.pn < 12) {
            const int col0 = (u.pn - 4) * HALF + wc * 32 + 8 * fq;
            PG8_FOR_AM { bf16_t* rowp = PB + (size_t)(row0 + ai * HALF + m * 16) * 1024 + col0;
                const f32x4 v0 = acc[ai][0][m][0] * acc[ai][1][m][0], v1 = acc[ai][0][m][1] * acc[ai][1][m][1]; u32x4 w;
                w.x = cvt_pk_bf16(v0[0], v0[1]); w.y = cvt_pk_bf16(v0[2], v0[3]); w.z = cvt_pk_bf16(v1[0], v1[1]); w.w = cvt_pk_bf16(v1[2], v1[3]);
                ST16_WT(rowp, w); }
        } else {
            const int col0 = (u.pn - 12) * BM + wc * 32 + 8 * fq;
            f32x4 bv[2][2];
#pragma unroll
            for (int bj = 0; bj < 2; ++bj)
#pragma unroll
                for (int n = 0; n < 2; ++n) bv[bj][n] = *(const f32x4*)(gb + col0 + bj * HALF + 4 * n);
            PG8_FOR_AM { unsigned char* rowp = GB + (size_t)(row0 + ai * HALF + m * 16) * 2048 + col0;
#pragma unroll
                for (int bj = 0; bj < 2; ++bj) {
                    f32x4 v0 = acc[ai][bj][m][0] + bv[bj][0], v1 = acc[ai][bj][m][1] + bv[bj][1]; unsigned a[4], b[4];
#pragma unroll
                    for (int i = 0; i < 4; ++i) { a[i] = __float_as_uint(fmaxf(sigmoidf_fast(v0[i]) * 255.0f, 1.0f) + 8388608.0f); b[i] = __float_as_uint(fmaxf(sigmoidf_fast(v1[i]) * 255.0f, 1.0f) + 8388608.0f); }
                    const u32x2 w = {__builtin_amdgcn_perm(a[1], a[0], 0x0c0c0400u) | __builtin_amdgcn_perm(a[3], a[2], 0x04000c0cu),
                                     __builtin_amdgcn_perm(b[1], b[0], 0x0c0c0400u) | __builtin_amdgcn_perm(b[3], b[2], 0x04000c0cu)};
                    ST8_WT(rowp + bj * HALF, w); } }
        }
    }
};
struct EpiGateOnly {
    static constexpr bool PERM = true;
    EpiConvGate c;
    __device__ __forceinline__ void operator()(const f32x4 (&acc)[2][2][4][2], const Unit& u, int wr, int wc, int fr, int fq) const { Unit v = u; v.pn = u.pn + 12; c(acc, v, wr, wc, fr, fq); }
};
struct EpiMul {
    static constexpr bool PERM = true;
    bf16_t* O; const bf16_t* G; int ldc;
    __device__ __forceinline__ void operator()(const f32x4 (&acc)[2][2][4][2], const Unit& u, int wr, int wc, int fr, int fq) const {
        const int row0 = u.pm * BM + wr * 64 + fr, col0 = u.pn * BM + wc * 32 + 8 * fq;
#pragma unroll
        for (int ai = 0; ai < 2; ++ai) {
            u32x4 g[4][2];
            if (G) {
#pragma unroll
                for (int m = 0; m < 4; ++m)
#pragma unroll
                    for (int bj = 0; bj < 2; ++bj) g[m][bj] = *(const u32x4*)(G + (size_t)(row0 + ai * HALF + m * 16) * ldc + col0 + bj * HALF);
            }
#pragma unroll
            for (int m = 0; m < 4; ++m) { const size_t off = (size_t)(row0 + ai * HALF + m * 16) * ldc + col0;
#pragma unroll
                for (int bj = 0; bj < 2; ++bj) { f32x4 v0 = acc[ai][bj][m][0], v1 = acc[ai][bj][m][1];
                    if (G) { const u32x4 gg = g[m][bj];
                        v0[0] *= bf_lo(gg.x); v0[1] *= bf_hi(gg.x); v0[2] *= bf_lo(gg.y); v0[3] *= bf_hi(gg.y); v1[0] *= bf_lo(gg.z); v1[1] *= bf_hi(gg.z); v1[2] *= bf_lo(gg.w); v1[3] *= bf_hi(gg.w); }
                    u32x4 w; w.x = cvt_pk_bf16(v0[0], v0[1]); w.y = cvt_pk_bf16(v0[2], v0[3]); w.z = cvt_pk_bf16(v1[0], v1[1]); w.w = cvt_pk_bf16(v1[2], v1[3]);
                    ST16_WT(O + off + bj * HALF, w); } }
        }
    }
};
struct EpiDual {
    static constexpr bool PERM = true; static constexpr bool CHAIN = true;
    bf16_t* O; const unsigned char* G;
    static __device__ __forceinline__ float ub0(unsigned w) { return (float)(w & 0xffu); }
    static __device__ __forceinline__ float ub1(unsigned w) { return (float)((w >> 8) & 0xffu); }
    static __device__ __forceinline__ float ub2(unsigned w) { return (float)((w >> 16) & 0xffu); }
    static __device__ __forceinline__ float ub3(unsigned w) { return (float)(w >> 24); }
    __device__ __forceinline__ void chain(f32x4 (&acc)[2][2][4][2], const Unit& u, int wr, int wc, int fr, int fq) const {
        const int row0 = u.pm * BM + wr * 64 + fr, col0 = u.pn * BM + wc * 32 + 8 * fq;
        if (u.e == 0) {
            u32x2 ga[2][4][2], gc[2][4][2];
#pragma unroll
            for (int ai = 0; ai < 2; ++ai)
#pragma unroll
                for (int m = 0; m < 4; ++m)
#pragma unroll
                    for (int bj = 0; bj < 2; ++bj) { const unsigned char* gp = G + (size_t)(row0 + ai * HALF + m * 16) * 2048 + col0 + bj * HALF;
                        ga[ai][m][bj] = *(const u32x2*)gp; gc[ai][m][bj] = *(const u32x2*)(gp + 1024); }
#pragma unroll
            for (int ai = 0; ai < 2; ++ai)
#pragma unroll
                for (int m = 0; m < 4; ++m)
#pragma unroll
                    for (int bj = 0; bj < 2; ++bj) { const u32x2 a = ga[ai][m][bj], c = gc[ai][m][bj];
                        acc[ai][bj][m][0][0] *= ub0(a.x) * __builtin_amdgcn_rcpf(ub0(c.x)); acc[ai][bj][m][0][1] *= ub1(a.x) * __builtin_amdgcn_rcpf(ub1(c.x));
                        acc[ai][bj][m][0][2] *= ub2(a.x) * __builtin_amdgcn_rcpf(ub2(c.x)); acc[ai][bj][m][0][3] *= ub3(a.x) * __builtin_amdgcn_rcpf(ub3(c.x));
                        acc[ai][bj][m][1][0] *= ub0(a.y) * __builtin_amdgcn_rcpf(ub0(c.y)); acc[ai][bj][m][1][1] *= ub1(a.y) * __builtin_amdgcn_rcpf(ub1(c.y));
                        acc[ai][bj][m][1][2] *= ub2(a.y) * __builtin_amdgcn_rcpf(ub2(c.y)); acc[ai][bj][m][1][3] *= ub3(a.y) * __builtin_amdgcn_rcpf(ub3(c.y)); }
        } else {
            u32x2 gc[2][4][2];
#pragma unroll
            for (int ai = 0; ai < 2; ++ai)
#pragma unroll
                for (int m = 0; m < 4; ++m)
#pragma unroll
                    for (int bj = 0; bj < 2; ++bj) gc[ai][m][bj] = *(const u32x2*)(G + (size_t)(row0 + ai * HALF + m * 16) * 2048 + 1024 + col0 + bj * HALF);
#pragma unroll
            for (int ai = 0; ai < 2; ++ai)
#pragma unroll
                for (int m = 0; m < 4; ++m)
#pragma unroll
                    for (int bj = 0; bj < 2; ++bj) { const u32x2 c = gc[ai][m][bj]; f32x4 v0 = acc[ai][bj][m][0] * (1.0f / 255.0f), v1 = acc[ai][bj][m][1] * (1.0f / 255.0f);
                        v0[0] *= ub0(c.x); v0[1] *= ub1(c.x); v0[2] *= ub2(c.x); v0[3] *= ub3(c.x); v1[0] *= ub0(c.y); v1[1] *= ub1(c.y); v1[2] *= ub2(c.y); v1[3] *= ub3(c.y);
                        u32x4 w; w.x = cvt_pk_bf16(v0[0], v0[1]); w.y = cvt_pk_bf16(v0[2], v0[3]); w.z = cvt_pk_bf16(v1[0], v1[1]); w.w = cvt_pk_bf16(v1[2], v1[3]);
                        ST16_WT(O + (size_t)(row0 + ai * HALF + m * 16) * 1024 + col0 + bj * HALF, w); }
        }
    }
};
struct EpiResid {
    static constexpr bool PERM = true;
    const bf16_t* H; bf16_t* V; float alpha;
    __device__ __forceinline__ void operator()(const f32x4 (&acc)[2][2][4][2], const Unit& u, int wr, int wc, int fr, int fq) const {
        const int row0 = u.pm * BM + wr * 64 + fr, col0 = u.pn * BM + wc * 32 + 8 * fq;
        u32x4 h[2][4][2];
#pragma unroll
        for (int ai = 0; ai < 2; ++ai)
#pragma unroll
            for (int m = 0; m < 4; ++m)
#pragma unroll
                for (int bj = 0; bj < 2; ++bj) h[ai][m][bj] = *(const u32x4*)(H + (size_t)(row0 + ai * HALF + m * 16) * 1024 + col0 + bj * HALF);
#pragma unroll
        for (int ai = 0; ai < 2; ++ai) {
#pragma unroll
            for (int m = 0; m < 4; ++m)
#pragma unroll
                for (int bj = 0; bj < 2; ++bj) { const u32x4 hh = h[ai][m][bj]; const f32x4 a0 = acc[ai][bj][m][0], a1 = acc[ai][bj][m][1]; u32x4 w;
                    w.x = cvt_pk_bf16(alpha * bf_lo(hh.x) + a0[0], alpha * bf_hi(hh.x) + a0[1]); w.y = cvt_pk_bf16(alpha * bf_lo(hh.y) + a0[2], alpha * bf_hi(hh.y) + a0[3]);
                    w.z = cvt_pk_bf16(alpha * bf_lo(hh.z) + a1[0], alpha * bf_hi(hh.z) + a1[1]); w.w = cvt_pk_bf16(alpha * bf_lo(hh.w) + a1[2], alpha * bf_hi(hh.w) + a1[3]);
                    ST16_WT(V + (size_t)(row0 + ai * HALF + m * 16) * 1024 + col0 + bj * HALF, w); }
        }
    }
};
struct EpiSilu {
    static constexpr bool PERM = true;
    bf16_t* O;
    __device__ __forceinline__ void operator()(const f32x4 (&acc)[2][2][4][2], const Unit& u, int wr, int wc, int fr, int fq) const {
        const int row0 = u.pm * BM + wr * 64 + fr, col0 = u.pn * HALF + wc * 32 + 8 * fq;
        PG8_FOR_AM { bf16_t* rowp = O + (size_t)(row0 + ai * HALF + m * 16) * 512 + col0; f32x4 v0, v1;
#pragma unroll
            for (int i = 0; i < 4; ++i) { const float a0 = acc[ai][0][m][0][i], a1 = acc[ai][0][m][1][i];
                v0[i] = a0 * sigmoidf_fast(a0) * acc[ai][1][m][0][i]; v1[i] = a1 * sigmoidf_fast(a1) * acc[ai][1][m][1][i]; }
            u32x4 w; w.x = cvt_pk_bf16(v0[0], v0[1]); w.y = cvt_pk_bf16(v0[2], v0[3]); w.z = cvt_pk_bf16(v1[0], v1[1]); w.w = cvt_pk_bf16(v1[2], v1[3]);
            ST16_WT(rowp, w); }
    }
};
struct EpiSilu8 {
    static constexpr bool PERM = true;
    unsigned char* O;
    __device__ __forceinline__ void operator()(const f32x4 (&acc)[2][2][4][2], const Unit& u, int wr, int wc, int fr, int fq) const {
        const int row0 = u.pm * BM + wr * 64 + fr, col0 = u.pn * HALF + wc * 32 + 8 * fq;
        PG8_FOR_AM { unsigned char* rowp = O + (size_t)(row0 + ai * HALF + m * 16) * 512 + col0; f32x4 v0, v1;
#pragma unroll
            for (int i = 0; i < 4; ++i) { const float a0 = acc[ai][0][m][0][i], a1 = acc[ai][0][m][1][i];
                v0[i] = a0 * sigmoidf_fast(a0) * acc[ai][1][m][0][i]; v1[i] = a1 * sigmoidf_fast(a1) * acc[ai][1][m][1][i]; }
            int w0 = 0, w1 = 0;
            w0 = __builtin_amdgcn_cvt_pk_fp8_f32(v0[0], v0[1], w0, false); w0 = __builtin_amdgcn_cvt_pk_fp8_f32(v0[2], v0[3], w0, true);
            w1 = __builtin_amdgcn_cvt_pk_fp8_f32(v1[0], v1[1], w1, false); w1 = __builtin_amdgcn_cvt_pk_fp8_f32(v1[2], v1[3], w1, true);
            const u32x2 w = {(unsigned)w0, (unsigned)w1};
            ST8_WT(rowp, w); }
    }
};
struct EpiOut8 {
    static constexpr bool PERM = true;
    unsigned char* O;
    __device__ __forceinline__ void operator()(const f32x4 (&acc)[2][2][4][2], const Unit& u, int wr, int wc, int fr, int fq) const {
        const int row0 = u.pm * BM + wr * 64 + fr, col0 = u.pn * BM + wc * 32 + 8 * fq;
        PG8_FOR_AM { unsigned char* rowp = O + (size_t)(row0 + ai * HALF + m * 16) * 1024 + col0;
#pragma unroll
            for (int bj = 0; bj < 2; ++bj) { const f32x4 v0 = acc[ai][bj][m][0], v1 = acc[ai][bj][m][1]; int w0 = 0, w1 = 0;
                w0 = __builtin_amdgcn_cvt_pk_fp8_f32(v0[0], v0[1], w0, false); w0 = __builtin_amdgcn_cvt_pk_fp8_f32(v0[2], v0[3], w0, true);
                w1 = __builtin_amdgcn_cvt_pk_fp8_f32(v1[0], v1[1], w1, false); w1 = __builtin_amdgcn_cvt_pk_fp8_f32(v1[2], v1[3], w1, true);
                const u32x2 w = {(unsigned)w0, (unsigned)w1};
                ST8_WT(rowp + bj * HALF, w); } }
    }
};

template <int K_> struct ProbDense { static constexpr bool FP8 = false;
    static constexpr int K = K_; static constexpr bool GATHER = false, MOE = false;
    const bf16_t* A; const bf16_t* Bt;
    __device__ __forceinline__ const char* abase(const Unit& u) const { return (const char*)A + (size_t)u.pm * (BM * K * 2); }
    __device__ __forceinline__ const char* bbase(const Unit& u) const { return (const char*)Bt + (size_t)u.pn * (BM * K * 2); }
    __device__ __forceinline__ const int* rows(const Unit&) const { return nullptr; }
};
template <int K_> struct ProbDense8 { static constexpr bool FP8 = true;
    static constexpr int K = K_; static constexpr bool GATHER = false, MOE = false;
    const bf16_t* A; const bf16_t* Bt;
    __device__ __forceinline__ const char* abase(const Unit& u) const { return (const char*)A + (size_t)u.pm * (BM * K * 2); }
    __device__ __forceinline__ const char* bbase(const Unit& u) const { return (const char*)Bt + (size_t)u.pn * (BM * K * 2); }
    __device__ __forceinline__ const int* rows(const Unit&) const { return nullptr; }
};
template <int K_> struct ProbDual { static constexpr bool FP8 = false;
    static constexpr int K = K_; static constexpr bool GATHER = false, MOE = false;
    const bf16_t* A0; const bf16_t* A1; const bf16_t* Bt;
    __device__ __forceinline__ const char* abase(const Unit& u) const { return (const char*)(u.e == 0 ? A0 : A1) + (size_t)u.pm * (BM * K * 2); }
    __device__ __forceinline__ const char* bbase(const Unit& u) const { return (const char*)Bt + (size_t)(u.e * 4 + u.pn) * (BM * K * 2); }
    __device__ __forceinline__ const int* rows(const Unit&) const { return nullptr; }
};
template <int K_, int NT_, bool GATHER_, bool FP8_ = false> struct ProbMoe { static constexpr bool FP8 = FP8_;
    static constexpr int K = K_; static constexpr bool GATHER = GATHER_, MOE = true;
    const bf16_t* A; const bf16_t* Bt; const int* rowtok; int cap;
    __device__ __forceinline__ const char* abase(const Unit& u) const { return GATHER ? (const char*)A : (const char*)A + (size_t)u.pm * (BM * K * 2); }
    __device__ __forceinline__ const char* bbase(const Unit& u) const { return (const char*)Bt + (size_t)(u.e * NT_ + u.pn) * (BM * K * 2); }
    __device__ __forceinline__ const int* rows(const Unit& u) const { return rowtok + (size_t)u.e * cap + u.lrow; }
};
struct DualOrder {
    StaticOrder S;
    __device__ __forceinline__ bool next(int i, Unit& u) const { if (!S.next(i >> 1, u)) return false; u.e = i & 1; return true; }
};
struct MoeOrder {
    const PG8_LAS int* tp; const PG8_LAS int* cnt; const PG8_LAS int* tt; int ncol, G, c;
    __device__ __forceinline__ bool next(int i, Unit& u) const {
        const int L = i * G + c; const int total = tp[32] * ncol; if (L >= total) return false;
        const int rt = L / ncol; u.pn = L - rt * ncol; const int ent = tt[rt], e = ent >> 16, tile = ent & 0xffff;
        u.pm = tp[e] + tile; u.e = e; u.lrow = tile * BM; const int rem = cnt[e] - u.lrow; u.nv = rem < BM ? rem : BM; return true;
    }
};

template <class E, class = void> struct is_chain { static constexpr bool value = false; };
template <class E> struct is_chain<E, decltype((void)E::CHAIN)> { static constexpr bool value = true; };
template <class Epi, class Prob, class Sched, bool ALIGN_EPI = true, bool SP2 = true>
__device__ __forceinline__ void gemm_phase(PG8_LAS unsigned char* lds, const Prob& P, const Sched& S, const Epi& E) {
    int tid_ = threadIdx.x; asm volatile("" : "+v"(tid_));
    const int tid = tid_, wid = __builtin_amdgcn_readfirstlane(tid >> 6), lane = tid & 63, wr = wid >> 2, wc = wid & 3, fr = lane & 15, fq = lane >> 4;
    constexpr int K = Prob::K, nt = K / BK;
    unsigned voffB[2], Cc[2]; int Rr[2];
#pragma unroll
    for (int i = 0; i < 2; ++i) { int R, C; stage_rc(tid * 16 + i * 8192, R, C); const int Rb = Epi::PERM ? ((R & ~31) + perm32(R & 31)) : R;
        voffB[i] = (unsigned)(Rb * K + C) * 2u; Rr[i] = R; Cc[i] = (unsigned)C * 2u; }
    constexpr size_t kstep = (size_t)(BK * 2);
    constexpr unsigned hstep = (unsigned)HALF * K * 2;
    const unsigned ldsw = (unsigned)wid * 1024u;
    const int aoff = lds_byte(wr * 64 + fr, fq * 8), boff = lds_byte(wc * 32 + fr, fq * 8);
    const int aoff8 = lds_byte(wr * 64 + fr, (fq >> 1) * 32 + (fq & 1) * 16), boff8 = lds_byte(wc * 32 + fr, (fq >> 1) * 32 + (fq & 1) * 16);
#define PG8_SA(b, h) (((b) * 2 + (h)) * HTB)
#define PG8_SB(b, h) ((4 + (b) * 2 + (h)) * HTB)
#define PG8_STAGE(bufoff, gbase, voff) do { _Pragma("unroll") for (int _i = 0; _i < 2; ++_i) \
        __builtin_amdgcn_global_load_lds((const unsigned*)((const char*)(gbase) + (voff)[_i]), (PG8_LAS unsigned*)(lds + (bufoff) + ldsw + _i * 8192), 16, 0, 0); } while (0)
#define PG8_LD8(p_) ({ typedef int v4i32_ __attribute__((ext_vector_type(4))); const v4i32_ lo_ = *(const PG8_LAS v4i32_*)(p_), hi_ = *(const PG8_LAS v4i32_*)((p_) + 16); __builtin_shufflevector(lo_, hi_, 0, 1, 2, 3, 4, 5, 6, 7); })
#define PG8_LDA(dst, b, h) do { if constexpr (Prob::FP8) { _Pragma("unroll") for (int m = 0; m < 4; ++m) dst##_8[m] = PG8_LD8(lds + PG8_SA(b, h) + aoff8 + m * 2048); } \
        else { _Pragma("unroll") for (int m = 0; m < 4; ++m) _Pragma("unroll") for (int k = 0; k < 2; ++k) dst[m][k] = *(const PG8_LAS bf16x8*)(lds + PG8_SA(b, h) + aoff + m * 2048 + k * 1024); } } while (0)
#define PG8_LDB(dst, b, h) do { if constexpr (Prob::FP8) { _Pragma("unroll") for (int n = 0; n < 2; ++n) dst##_8[n] = PG8_LD8(lds + PG8_SB(b, h) + boff8 + n * 2048); } \
        else { _Pragma("unroll") for (int n = 0; n < 2; ++n) _Pragma("unroll") for (int k = 0; k < 2; ++k) dst[n][k] = *(const PG8_LAS bf16x8*)(lds + PG8_SB(b, h) + boff + n * 2048 + k * 1024); } } while (0)
#define PG8_MMA(ai, bj, At, Bt) do { __builtin_amdgcn_s_setprio(1); \
        if constexpr (Prob::FP8) { _Pragma("unroll") for (int m = 0; m < 4; ++m) _Pragma("unroll") for (int n = 0; n < 2; ++n) \
            asm volatile("v_mfma_scale_f32_16x16x128_f8f6f4 %0, %1, %2, %0, %3, %4 op_sel_hi:[0,0,0]" : "+v"(acc[ai][bj][m][n]) : "v"(Bt##_8[n]), "v"(At##_8[m]), "v"(sc_w8), "v"(sc_a8)); } \
          \
        else { _Pragma("unroll") for (int m = 0; m < 4; ++m) _Pragma("unroll") for (int n = 0; n < 2; ++n) _Pragma("unroll") for (int k = 0; k < 2; ++k) \
            acc[ai][bj][m][n] = __builtin_amdgcn_mfma_f32_16x16x32_bf16(Bt[n][k], At[m][k], acc[ai][bj][m][n], 0, 0, 0); } \
        __builtin_amdgcn_s_setprio(0); } while (0)
#define PG8_WAIT_V(n) asm volatile("s_waitcnt vmcnt(" #n ")" ::: "memory")
#define PG8_WAIT_L(n) asm volatile("s_waitcnt lgkmcnt(" #n ")" ::: "memory")
#define PG8_BAR __builtin_amdgcn_s_barrier()
#define PG8_SCHED __builtin_amdgcn_sched_barrier(0)
#define PG8_LOADVA(va, u) do { if constexpr (Prob::GATHER) { const int* rl_ = P.rows(u); \
        _Pragma("unroll") for (int h_ = 0; h_ < 2; ++h_) _Pragma("unroll") for (int i_ = 0; i_ < 2; ++i_) { const int r_ = h_ * HALF + Rr[i_]; const int tok_ = (r_ < (u).nv) ? rl_[r_] : 0; \
            va[h_][i_] = (unsigned)tok_ * (unsigned)(K * 2) + Cc[i_]; } } \
      else { _Pragma("unroll") for (int h_ = 0; h_ < 2; ++h_) _Pragma("unroll") for (int i_ = 0; i_ < 2; ++i_) va[h_][i_] = (unsigned)(Rr[i_] * K * 2) + Cc[i_] + (unsigned)h_ * hstep; } } while (0)
    Unit cur, nxt; int ui = 0;
    if (!S.next(0, cur)) return;
    f32x4 acc[2][2][4][2];
#pragma unroll
    for (int a = 0; a < 2; ++a)
#pragma unroll
        for (int b = 0; b < 2; ++b)
#pragma unroll
            for (int m = 0; m < 4; ++m)
#pragma unroll
                for (int n = 0; n < 2; ++n) acc[a][b][m][n] = (f32x4){0.f, 0.f, 0.f, 0.f};
    bf16x8 At[4][2], B0[2][2], B1[2][2]; v8i32 At_8[4], B0_8[2], B1_8[2];
    int sc_w8 = 0x7a7a7a7a, sc_a8 = 0x7f7f7f7f;
    unsigned vaC[2][2], vaN[2][2];
    PG8_LOADVA(vaC, cur);
    const char* cA = P.abase(cur); const char* cB = P.bbase(cur);
    PG8_STAGE(PG8_SB(0, 0), cB, voffB); PG8_STAGE(PG8_SB(0, 1), cB + hstep, voffB); PG8_STAGE(PG8_SA(0, 0), cA, vaC[0]); PG8_STAGE(PG8_SA(0, 1), cA, vaC[1]);
    if (wr == 1) PG8_BAR;
    PG8_WAIT_V(2); PG8_BAR;
    PG8_STAGE(PG8_SB(1, 0), cB + kstep, voffB); PG8_STAGE(PG8_SA(1, 0), cA + kstep, vaC[0]); PG8_STAGE(PG8_SB(1, 1), cB + hstep + kstep, voffB);
    PG8_WAIT_V(6); PG8_BAR;
    for (;;) {
        const bool has_next = S.next(ui + 1, nxt);
        const bool lower_half = !Prob::MOE || cur.nv > HALF;
        const char* nA = has_next ? P.abase(nxt) : cA; const char* nB = has_next ? P.bbase(nxt) : cB;
        if constexpr (Prob::GATHER) { if (has_next) { PG8_LOADVA(vaN, nxt); } else {
#pragma unroll
            for (int h = 0; h < 2; ++h)
#pragma unroll
                for (int i = 0; i < 2; ++i) vaN[h][i] = vaC[h][i]; } }

#pragma unroll 1
        for (int t = 0; t < nt; t += 2) {
            const bool last = (t == nt - 2);
            const char* a1 = cA + (size_t)(t + 1) * kstep;
            const char* a2 = last ? nA : cA + (size_t)(t + 2) * kstep; const char* b2 = last ? nB : cB + (size_t)(t + 2) * kstep;
            const char* a3 = a2 + kstep; const char* b3 = b2 + kstep;
            unsigned v2[2][2];
#pragma unroll
            for (int h = 0; h < 2; ++h)
#pragma unroll
                for (int i = 0; i < 2; ++i) { if constexpr (Prob::GATHER) v2[h][i] = last ? vaN[h][i] : vaC[h][i]; else v2[h][i] = vaC[h][i]; }
            PG8_LDB(B0, 0, 0); PG8_LDB(B1, 0, 1); PG8_SCHED; PG8_LDA(At, 0, 0); PG8_STAGE(PG8_SA(1, 1), a1, vaC[1]);
            PG8_WAIT_V(8); PG8_WAIT_L(0); PG8_BAR; PG8_MMA(0, 0, At, B0); PG8_MMA(0, 1, At, B1); PG8_BAR; PG8_SCHED;
            PG8_LDA(At, 0, 1); PG8_STAGE(PG8_SB(0, 0), b2, voffB); PG8_STAGE(PG8_SB(0, 1), b2 + hstep, voffB); PG8_STAGE(PG8_SA(0, 0), a2, v2[0]);
            PG8_WAIT_V(8); PG8_WAIT_L(0); PG8_BAR; if (lower_half) { PG8_MMA(1, 0, At, B0); PG8_MMA(1, 1, At, B1); } PG8_BAR; PG8_SCHED;
            PG8_LDB(B0, 1, 0); PG8_LDB(B1, 1, 1); PG8_SCHED; PG8_LDA(At, 1, 0); PG8_STAGE(PG8_SA(0, 1), a2, v2[1]);
            PG8_WAIT_V(8); PG8_WAIT_L(0); PG8_BAR; PG8_MMA(0, 0, At, B0); PG8_MMA(0, 1, At, B1); PG8_BAR; PG8_SCHED;
            PG8_LDA(At, 1, 1); PG8_STAGE(PG8_SB(1, 0), b3, voffB); PG8_STAGE(PG8_SB(1, 1), b3 + hstep, voffB); PG8_STAGE(PG8_SA(1, 0), a3, v2[0]);
            PG8_WAIT_V(8); PG8_WAIT_L(0); PG8_BAR; if (lower_half) { PG8_MMA(1, 0, At, B0); PG8_MMA(1, 1, At, B1); } PG8_BAR; PG8_SCHED;
        }
        if constexpr (ALIGN_EPI) { if (wr == 0) PG8_BAR; }
        if constexpr (Prob::FP8) asm volatile("s_nop 15\n\ts_nop 15\n\ts_nop 7" ::: "memory");
        if constexpr (is_chain<Epi>::value) E.chain(acc, cur, wr, wc, fr, fq); else E(acc, cur, wr, wc, fr, fq);
        if (!has_next) break;
        if (!(is_chain<Epi>::value && cur.e == 0))
#pragma unroll
        for (int a = 0; a < 2; ++a)
#pragma unroll
            for (int b = 0; b < 2; ++b)
#pragma unroll
                for (int m = 0; m < 4; ++m)
#pragma unroll
                    for (int n = 0; n < 2; ++n) acc[a][b][m][n] = (f32x4){0.f, 0.f, 0.f, 0.f};
        cur = nxt; cA = nA; cB = nB; ++ui;
        if constexpr (Prob::GATHER) {
#pragma unroll
            for (int h = 0; h < 2; ++h)
#pragma unroll
                for (int i = 0; i < 2; ++i) vaC[h][i] = vaN[h][i]; }
        if constexpr (ALIGN_EPI) { if (wr == 1) PG8_BAR; }
    }
    PG8_WAIT_V(0);
    if constexpr (!ALIGN_EPI) { if (wr == 0) PG8_BAR; }
    PG8_BAR;
#undef PG8_SA
#undef PG8_SB
#undef PG8_STAGE
#undef PG8_LDA
#undef PG8_LDB
#undef PG8_MMA
#undef PG8_WAIT_V
#undef PG8_WAIT_L
#undef PG8_BAR
#undef PG8_SCHED
#undef PG8_LOADVA
}
}
namespace attn_body {
using bf16=__hip_bfloat16;
using bf16x8=__attribute__((ext_vector_type(8)))short;
using s16x4=__attribute__((ext_vector_type(4)))short;
using f32x16=__attribute__((ext_vector_type(16)))float;
using u32x4=__attribute__((ext_vector_type(4)))unsigned;
constexpr int SEQ=16384,D=64,DV=128,DM=1024;
constexpr int NW=8,QBLK=32,QB=QBLK*NW,KVBLK=64,NQB=SEQ/QB;
constexpr int ATTN_PITCH=DM, ATTN_UNIT_ROWS=QB;
__device__ __forceinline__ int crow(int r,int hi){return (r&3)+8*(r>>2)+4*hi;}
#define SBAR() __builtin_amdgcn_sched_barrier(0)
typedef const __attribute__((address_space(3))) float* lds_cfptr;
constexpr int TBP=96, TBW=320;
#define CMB 4
__device__ __forceinline__ void cmask(f32x16&p0,f32x16&p1,int jb,int qrel,int hi,int wid,lds_cfptr tb){
  const int minD=wid*32-64*jb-63;
  if(minD>=127)return;
  if(minD<-94){
    #pragma unroll
    for(int r=0;r<16;++r){p0[r]=-INFINITY;p1[r]=-INFINITY;}
    return;}
  const lds_cfptr bp=tb+(qrel-64*jb-4*hi+(TBP-59));
  #pragma unroll
  for(int g=0;g<16;g+=CMB){ float t0[CMB],t1[CMB];
    #pragma unroll
    for(int q=0;q<CMB;++q){const int r=g+q,c=(r&3)+8*(r>>2); t0[q]=bp[59-c]; t1[q]=bp[27-c];}
    #if CMB==8
    asm volatile("":"+v"(t0[0]),"+v"(t0[1]),"+v"(t0[2]),"+v"(t0[3]),"+v"(t0[4]),"+v"(t0[5]),"+v"(t0[6]),"+v"(t0[7]),"+v"(t1[0]),"+v"(t1[1]),"+v"(t1[2]),"+v"(t1[3]),"+v"(t1[4]),"+v"(t1[5]),"+v"(t1[6]),"+v"(t1[7]));
    #else
    asm volatile("":"+v"(t0[0]),"+v"(t0[1]),"+v"(t0[2]),"+v"(t0[3]),"+v"(t1[0]),"+v"(t1[1]),"+v"(t1[2]),"+v"(t1[3]));
    #endif
    #pragma unroll
    for(int q=0;q<CMB;++q){p0[g+q]+=t0[q]; p1[g+q]+=t1[q];} }
}

constexpr int NSLOT=3, KSLOT=8192, VSLOT=16384;
constexpr int LDS_K=0, LDS_V=NSLOT*KSLOT, LDS_WS=LDS_V+NSLOT*VSLOT, LDS_OST=LDS_WS+NW*64*4, LDS_BYTES=LDS_OST+NW*8192;
constexpr int LDS_VOTE=152576;
constexpr float C2=0.125f*1.4426950408889634f;
template<int OFF> __device__ __forceinline__ void glds16(const void*sbase,unsigned voff,unsigned lds_dst){unsigned keep;
  asm volatile("s_mov_b32 %0, m0\n\ts_mov_b32 m0, %2\n\ts_nop 0\n\tglobal_load_lds_dwordx4 %1, %3 offset:%c4\n\ts_mov_b32 m0, %0":"=&s"(keep):"v"(voff),"s"(lds_dst),"s"(sbase),"i"(OFF):"memory");}
__device__ __forceinline__ float max3f(float a,float b,float c){float r;asm("v_max3_f32 %0, %1, %2, %3":"=v"(r):"v"(a),"v"(b),"v"(c));return r;}
__device__ __forceinline__ float max2f(float a,float b){float r;asm("v_max_f32_e32 %0, %1, %2":"=v"(r):"v"(a),"v"(b));return r;}
typedef float f32x2_t __attribute__((ext_vector_type(2))); typedef __bf16 bf16x2_t __attribute__((ext_vector_type(2)));
__device__ __forceinline__ unsigned cvtpk_s(float lo,float hi){f32x2_t v={lo,hi};bf16x2_t b=__builtin_convertvector(v,bf16x2_t);return __builtin_bit_cast(unsigned,b);}
#define WAIT_BAR(N) asm volatile("s_waitcnt vmcnt(" #N ") lgkmcnt(0)\n\ts_barrier":::"memory")
#define MFMA32(a,b,c) __builtin_amdgcn_mfma_f32_32x32x16_bf16(a,b,c,0,0,0)

__device__ __forceinline__ void qkt(f32x16&p0,f32x16&p1,const char*Kslot,const bf16x8*qr,int r32,int hi){
  const char*kb=Kslot+hi*1024+r32*16; const f32x16 z=f32x16{};
  #pragma unroll
  for(int d0=0;d0<4;++d0){
    const bf16x8 b0=*reinterpret_cast<const bf16x8*>(kb+d0*2048);
    const bf16x8 b1=*reinterpret_cast<const bf16x8*>(kb+d0*2048+512);
    if(d0==0){p0=MFMA32(b0,qr[0],z);p1=MFMA32(b1,qr[0],z);}
    else{p0=MFMA32(b0,qr[d0],p0);p1=MFMA32(b1,qr[d0],p1);}}
}
typedef __attribute__((address_space(3))) const char* lds_cptr;
typedef short v4i16_t __attribute__((ext_vector_type(4)));
__device__ __forceinline__ void kload8(bf16x8*kf,lds_cptr kp){
  kf[0]=*(const __attribute__((address_space(3))) bf16x8*)(kp);      kf[1]=*(const __attribute__((address_space(3))) bf16x8*)(kp+512);
  kf[2]=*(const __attribute__((address_space(3))) bf16x8*)(kp+2048); kf[3]=*(const __attribute__((address_space(3))) bf16x8*)(kp+2560);
  kf[4]=*(const __attribute__((address_space(3))) bf16x8*)(kp+4096); kf[5]=*(const __attribute__((address_space(3))) bf16x8*)(kp+4608);
  kf[6]=*(const __attribute__((address_space(3))) bf16x8*)(kp+6144); kf[7]=*(const __attribute__((address_space(3))) bf16x8*)(kp+6656);
}
__device__ __forceinline__ void kload2(bf16x8*kf,lds_cptr kp,int j){ kf[2*j]=*(const __attribute__((address_space(3))) bf16x8*)(kp+j*2048); kf[2*j+1]=*(const __attribute__((address_space(3))) bf16x8*)(kp+j*2048+512); }
__device__ __forceinline__ s16x4 vtr(lds_cptr p){ return __builtin_bit_cast(s16x4,__builtin_amdgcn_ds_read_tr16_b64_v4i16((__attribute__((address_space(3))) v4i16_t*)p)); }
__device__ __forceinline__ float rowmax(const f32x16&p0,const f32x16&p1){
  float a=max3f(p0[0],p0[1],p1[0]),b=max3f(p0[2],p0[3],p1[1]);a=max3f(a,p1[2],p1[3]);
  #pragma unroll
  for(int r=4;r<16;r+=4){a=max3f(a,p0[r],p0[r+1]);b=max3f(b,p0[r+2],p0[r+3]);a=max3f(a,p1[r],p1[r+1]);b=max3f(b,p1[r+2],p1[r+3]);}
  const float m=max2f(a,b);
  auto rr=__builtin_amdgcn_permlane32_swap(__float_as_uint(m),__float_as_uint(m),false,false);
  return max2f(__uint_as_float(rr[0]),__uint_as_float(rr[1]));
}
__device__ __forceinline__ void pv(f32x16*o,int vb,bf16x8 pa0,bf16x8 pa1,bf16x8 pa2,bf16x8 pa3){
  #pragma unroll
  for(int d0=0;d0<4;++d0){s16x4 lo[4],hi[4];
    #pragma unroll
    for(int ks=0;ks<4;++ks){
      asm volatile("ds_read_b64_tr_b16 %0,%1 offset:%c2":"=&v"(lo[ks]):"v"(vb),"i"(d0*4096+ks*1024):"memory");
      asm volatile("ds_read_b64_tr_b16 %0,%1 offset:%c2":"=&v"(hi[ks]):"v"(vb),"i"(d0*4096+ks*1024+512):"memory");}
    asm volatile("s_waitcnt lgkmcnt(0)":::"memory");SBAR();
    #define PK(k) (bf16x8){lo[k][0],lo[k][1],lo[k][2],lo[k][3],hi[k][0],hi[k][1],hi[k][2],hi[k][3]}
    o[d0]=MFMA32(pa0,PK(0),o[d0]);
    o[d0]=MFMA32(pa1,PK(1),o[d0]);
    o[d0]=MFMA32(pa2,PK(2),o[d0]);
    o[d0]=MFMA32(pa3,PK(3),o[d0]);
    #undef PK
  }
}

#ifndef ATTN_STORE16
#define ATTN_STORE16(p,v) ST16_WT(p,v)
#endif
template<int THRL,int VAR,bool FAST> __device__ __forceinline__ bool attn_unit(int b,int hq,int h,int qb,int half,float lam,float osc,const float*subg,const bf16*Q,const bf16*__restrict__ K,const bf16*__restrict__ V,bf16*O,char*shm,lds_cfptr tb){
  int tid_=threadIdx.x; asm volatile("":"+v"(tid_)); const int tid=tid_,lane=tid&63,r32=lane&31,hi=lane>>5; const int wid=__builtin_amdgcn_readfirstlane(tid>>6);
  const long rowbase=(long)b*SEQ; const int q0=qb*QB;
  const bf16*Qw=Q+(rowbase+q0+wid*QBLK)*DM+hq*D;
  const bf16*Kh=K+rowbase*DM+hq*D,*Vh=V+rowbase*DM+h*DV;
  const unsigned lds0=(unsigned)(uintptr_t)shm;
  float*wsf=(float*)(shm+LDS_WS)+wid*64;
  const unsigned kvo=(unsigned)(lane*DM+wid*8)*2u;
  const unsigned vvo=(unsigned)((16*(wid&3)+(lane>>2))*DM+(wid>>2)*32+(lane&3)*8)*2u;
  const unsigned kdst=lds0+LDS_K+wid*1024, vdst=lds0+LDS_V+wid*1024;
  #define DMA_K(t,slot) glds16<0>(Kh+(long)(t)*KVBLK*DM,kvo,(unsigned)__builtin_amdgcn_readfirstlane(kdst+(slot)))
  #define DMA_V0(t,slot) glds16<0>(Vh+(long)(t)*KVBLK*DM,vvo,(unsigned)__builtin_amdgcn_readfirstlane(vdst+2*(slot)))
  #define DMA_V1(t,slot) glds16<0>(Vh+(long)(t)*KVBLK*DM+64,vvo,(unsigned)__builtin_amdgcn_readfirstlane(vdst+2*(slot)+8192))
  #define DMA_V(t,slot) do{ DMA_V0(t,slot); DMA_V1(t,slot); }while(0)
  const char*Kbase=shm+LDS_K; bf16x8 kf[8];
  const lds_cptr shm3=(lds_cptr)shm; const lds_cptr kp0=shm3+LDS_K+hi*1024+r32*16; const lds_cptr vp0=shm3+LDS_V+((lane>>4)&1)*32+(lane&3)*8+(4*hi+((lane&15)>>2))*64;
  const int NT=(q0+QB)/KVBLK;
  DMA_K(0,0);DMA_V(0,0);DMA_K(1,KSLOT);
  bf16x8 qr[4];
  #pragma unroll
  for(int d0=0;d0<4;++d0)qr[d0]=*reinterpret_cast<const bf16x8*>(&Qw[(long)r32*DM+d0*16+hi*8]);
  float mhat=0.f,l_reg=0.f;f32x16 o[4];o[0]=f32x16{};o[1]=f32x16{};o[2]=f32x16{};o[3]=f32x16{};
  bool slow=false;
  const int qrel=wid*QBLK+r32;
  #define CMASK(P0,P1,t) do{int jb_=(t)-(NT-4); if(jb_>=-2)cmask(P0,P1,jb_,qrel,hi,wid,tb);}while(0)
  bool resc=false;
  #define START(P0,P1) do{ resc=false; \
    if constexpr(!FAST){ const float rm=rowmax(P0,P1); \
    if(__builtin_expect(__any(__builtin_fabsf(rm)>(float)THRL),0)){ mhat=rm; slow=true; \
      _Pragma("unroll") for(int r=0;r<16;++r){P0[r]-=rm;P1[r]-=rm;} } } \
    _Pragma("unroll") for(int r=0;r<16;++r)P0[r]=__builtin_amdgcn_exp2f(P0[r]); }while(0)
  #define RESC() do{ if(resc){ asm volatile("s_waitcnt lgkmcnt(0)":::"memory"); \
      _Pragma("unroll") for(int d_=0;d_<4;++d_) _Pragma("unroll") for(int r=0;r<16;++r)o[d_][r]*=wsf[crow(r,hi)]; } }while(0)
  f32x16 pA0,pA1,pB0,pB1; if((VAR)&8){pA0=f32x16{};pA1=f32x16{};pB0=f32x16{};pB1=f32x16{};}
  int sl_prev=0,sl_cur=0,sl_next=KSLOT;
  #define ROT() do{sl_prev=sl_cur;sl_cur=sl_next;sl_next=(sl_next==(NSLOT-1)*KSLOT)?0:sl_next+KSLOT;}while(0)
  DMA_K(2,2*KSLOT);
  WAIT_BAR(4);
  qkt(pA0,pA1,Kbase,qr,r32,hi);asm volatile("s_nop 15\n\ts_nop 7":"+v"(pA0),"+v"(pA1));CMASK(pA0,pA1,0);
  START(pA0,pA1);
  _Pragma("unroll") for(int r=0;r<16;++r)pA1[r]=__builtin_amdgcn_exp2f(pA1[r]);
  WAIT_BAR(0);
  DMA_K(3,0);DMA_V(1,KSLOT);
  ROT();
  kload8(kf,kp0+sl_cur);
  WAIT_BAR(3);
  s16x4 vlo[8],vhi[8]; u32x4 pw0,pw1,pw2,pw3;
  if((VAR)&2){ _Pragma("unroll") for(int i_=0;i_<8;++i_){vlo[i_]=s16x4{};vhi[i_]=s16x4{};} }
  const f32x16 zero16=f32x16{};
  #define PKW(P,B) cvtpk_s(P[B],P[B+1])
  #define PAF(k) __builtin_bit_cast(bf16x8,pw##k)
  #define VFR(i) (bf16x8){vlo[i][0],vlo[i][1],vlo[i][2],vlo[i][3],vhi[i][0],vhi[i][1],vhi[i][2],vhi[i][3]}
  #define PIN(x) asm volatile("":"+v"(x))
  #define MX3(a,b,c) __builtin_fmaxf(__builtin_fmaxf((a),(b)),(c))
  #define GAPA(MF,A0,A1,A2,A3,W0,W1,PW) do{ if(!((VAR)&8)){ MF; } sacc+=A0; sacc+=A1; sacc+=A2; sacc+=A3; PIN(sacc); W0; W1; PIN(PW); SBAR(); }while(0)
  #define EX(v) (((VAR)&1)?(v):__builtin_amdgcn_exp2f(v))
  #define GAPB(MF,X,B) do{ if(!((VAR)&4)){ MF; } X[B]=EX(X[B]); X[B+1]=EX(X[B+1]); PIN(X); SBAR(); }while(0)
  #define GAPB3(MF,X,B) do{ if(!((VAR)&4)){ MF; } X[B]=EX(X[B]); X[B+1]=EX(X[B+1]); X[B+2]=EX(X[B+2]); PIN(X); SBAR(); }while(0)
  #define GAPB3X(MF,XA,XB) do{ if(!((VAR)&4)){ MF; } XA[15]=EX(XA[15]); XB[0]=EX(XB[0]); XB[1]=EX(XB[1]); PIN(XA); PIN(XB); SBAR(); }while(0)
  #define PVA(MF) do{ if(!((VAR)&4)){ MF; } }while(0)
  #define VRD(s,f) do{ if(!((VAR)&2)){ vlo[s]=vtr(vp_+(((f)>>2)*4096+((f)&3)*1024)); vhi[s]=vtr(vp_+(((f)>>2)*4096+((f)&3)*1024+512)); } }while(0)
  #define KRD(G,j) do{ if((G)&&!((VAR)&16)){ kload2(kf,kp0+sl_next,j); SBAR(); } }while(0)
  #define STEP(C0,C1,P0,P1,t,GK,GV,GL) do{ SBAR(); \
    const lds_cptr vp_=vp0+2*sl_prev; \
    VRD(0,0); SBAR(); float sacc=(P0[0]+P0[1]); \
    GAPA(C0=MFMA32(kf[0],qr[0],zero16), P0[2],P0[3],P0[4],P0[5],     pw0[0]=PKW(P0,0), pw0[1]=PKW(P0,2), pw0); \
    VRD(4,4); SBAR(); GAPA(C1=MFMA32(kf[1],qr[0],zero16), P0[6],P0[7],P0[8],P0[9],     pw0[2]=PKW(P0,4), pw0[3]=PKW(P0,6), pw0); \
    VRD(1,1); SBAR(); GAPA(C0=MFMA32(kf[2],qr[1],C0),   P0[10],P0[11],P0[12],P0[13], pw1[0]=PKW(P0,8), pw1[1]=PKW(P0,10), pw1); \
    VRD(5,5); SBAR(); GAPA(C1=MFMA32(kf[3],qr[1],C1),   P0[14],P0[15],P1[0],P1[1],   pw1[2]=PKW(P0,12),pw1[3]=PKW(P0,14), pw1); \
    VRD(2,2); SBAR(); GAPA(C0=MFMA32(kf[4],qr[2],C0),   P1[2],P1[3],P1[4],P1[5],     pw2[0]=PKW(P1,0), pw2[1]=PKW(P1,2), pw2); PVA(o[0]=MFMA32(PAF(0),VFR(0),o[0])); if(!((VAR)&128)){VRD(0,8);}  SBAR(); if((GK)&&!((VAR)&64)){DMA_K((t)+3,sl_cur);SBAR();} \
    VRD(6,6); SBAR(); GAPA(C1=MFMA32(kf[5],qr[2],C1),   P1[6],P1[7],P1[8],P1[9],     pw2[2]=PKW(P1,4), pw2[3]=PKW(P1,6), pw2); PVA(o[1]=MFMA32(PAF(0),VFR(4),o[1])); if(!((VAR)&128)){VRD(4,12);} SBAR(); if((GV)&&!((VAR)&32)){DMA_V0((t)+1,sl_next);SBAR();} \
    VRD(3,3); SBAR(); GAPA(C0=MFMA32(kf[6],qr[3],C0),   P1[10],P1[11],P1[12],P1[13], pw3[0]=PKW(P1,8), pw3[1]=PKW(P1,10), pw3); PVA(o[0]=MFMA32(PAF(1),VFR(1),o[0])); if(!((VAR)&128)){VRD(1,9);}  SBAR(); if((GV)&&!((VAR)&32)){DMA_V1((t)+1,sl_next);SBAR();} \
    VRD(7,7); SBAR(); GAPA(C1=MFMA32(kf[7],qr[3],C1),   P1[14],P1[15],0.f,0.f,       pw3[2]=PKW(P1,12),pw3[3]=PKW(P1,14), pw3); PVA(o[1]=MFMA32(PAF(1),VFR(5),o[1])); if(!((VAR)&128)){VRD(5,13);} SBAR(); \
    l_reg+=sacc; \
    if constexpr(!FAST){ if(__builtin_expect(slow,0)){ _Pragma("unroll") for(int r=0;r<16;++r){C0[r]-=mhat;C1[r]-=mhat;} } } \
    CMASK(C0,C1,t); \
    if constexpr(FAST){ resc=false; } else { float a=MX3(C0[0],C0[1],C1[0]),b=MX3(C0[2],C0[3],C1[1]); a=MX3(a,C1[2],C1[3]); \
      _Pragma("unroll") for(int r=4;r<16;r+=4){a=MX3(a,C0[r],C0[r+1]);b=MX3(b,C0[r+2],C0[r+3]);a=MX3(a,C1[r],C1[r+1]);b=MX3(b,C1[r+2],C1[r+3]);} \
      float rm=__builtin_fmaxf(a,b); { auto rr=__builtin_amdgcn_permlane32_swap(__float_as_uint(rm),__float_as_uint(rm),false,false); rm=__builtin_fmaxf(__uint_as_float(rr[0]),__uint_as_float(rr[1])); } \
      resc=false; \
      if(__builtin_expect(__any(rm>(float)THRL),0)){ const float dl=__builtin_fmaxf(rm,0.f); mhat+=dl; slow=true; \
        _Pragma("unroll") for(int r=0;r<16;++r){C0[r]-=dl;C1[r]-=dl;} \
        const float f=__builtin_amdgcn_exp2f(-dl); l_reg*=f; if(hi==0)wsf[r32]=f; resc=true; } } \
    SBAR(); \
    GAPB3(o[0]=MFMA32(PAF(2),VFR(2),o[0]), C0,0);  VRD(2,10); SBAR(); \
    GAPB3(o[1]=MFMA32(PAF(2),VFR(6),o[1]), C0,3);  VRD(6,14); SBAR(); \
    GAPB3(o[0]=MFMA32(PAF(3),VFR(3),o[0]), C0,6);  VRD(3,11); SBAR(); \
    GAPB3(o[1]=MFMA32(PAF(3),VFR(7),o[1]), C0,9);  VRD(7,15); SBAR(); \
    KRD(GL,0); GAPB3(o[2]=MFMA32(PAF(0),VFR(0),o[2]), C0,12); \
    KRD(GL,1); GAPB3X(o[3]=MFMA32(PAF(0),VFR(4),o[3]), C0,C1); \
    KRD(GL,2); GAPB3(o[2]=MFMA32(PAF(1),VFR(1),o[2]), C1,2); \
    KRD(GL,3); GAPB3(o[3]=MFMA32(PAF(1),VFR(5),o[3]), C1,5); \
    GAPB(o[2]=MFMA32(PAF(2),VFR(2),o[2]), C1,8); \
    GAPB(o[3]=MFMA32(PAF(2),VFR(6),o[3]), C1,10); \
    GAPB(o[2]=MFMA32(PAF(3),VFR(3),o[2]), C1,12); \
    GAPB(o[3]=MFMA32(PAF(3),VFR(7),o[3]), C1,14); \
    }while(0)
  int t=1;
  #undef CMASK
  #define CMASK(P0,P1,t) do{}while(0)
  for(;t+7<NT;t+=2){
    STEP(pB0,pB1,pA0,pA1,t,true,true,true);     WAIT_BAR(3); RESC(); ROT();
    STEP(pA0,pA1,pB0,pB1,t+1,true,true,true);   WAIT_BAR(3); RESC(); ROT();
  }
  #undef CMASK
  #define CMASK(P0,P1,t) do{int jb_=(t)-(NT-4); if(jb_>=-2)cmask(P0,P1,jb_,qrel,hi,wid,tb);}while(0)
  #define ENDW(tt) do{ if((tt)+3<NT){WAIT_BAR(3);} else if((tt)+2<NT){WAIT_BAR(2);} else {WAIT_BAR(0);} }while(0)
  for(;t+1<NT;t+=2){
    STEP(pB0,pB1,pA0,pA1,t,(t+3<NT),(t+1<NT),(t+1<NT));       ENDW(t);   RESC(); ROT();
    STEP(pA0,pA1,pB0,pB1,t+1,(t+4<NT),(t+2<NT),(t+2<NT));     ENDW(t+1); RESC(); ROT();
  }
  STEP(pB0,pB1,pA0,pA1,NT-1,false,false,false); RESC();
  { float sacc=pB0[0]+pB0[1]; _Pragma("unroll") for(int r=2;r<16;++r)sacc+=pB0[r]; _Pragma("unroll") for(int r=0;r<16;++r)sacc+=pB1[r]; l_reg+=sacc;
    pw0=(u32x4){PKW(pB0,0),PKW(pB0,2),PKW(pB0,4),PKW(pB0,6)};pw1=(u32x4){PKW(pB0,8),PKW(pB0,10),PKW(pB0,12),PKW(pB0,14)};pw2=(u32x4){PKW(pB1,0),PKW(pB1,2),PKW(pB1,4),PKW(pB1,6)};pw3=(u32x4){PKW(pB1,8),PKW(pB1,10),PKW(pB1,12),PKW(pB1,14)};
    SBAR(); pv(o,(int)(unsigned)(uintptr_t)(vp0+2*sl_cur),PAF(0),PAF(1),PAF(2),PAF(3)); }
  #undef PKW
  #undef PAF
  #undef VFR
  #undef PIN
  #undef MX3
  #undef GAPA
  #undef GAPB
  #undef GAPB3
  #undef GAPB3X
  #undef PVA
  #undef EX
  #undef VRD
  #undef KRD
  #undef STEP
  #undef ENDW
  {auto rr=__builtin_amdgcn_permlane32_swap(__float_as_uint(l_reg),__float_as_uint(l_reg),false,false);l_reg=__uint_as_float(rr[0])+__uint_as_float(rr[1]);}
  if constexpr(FAST){
    volatile __attribute__((address_space(3))) unsigned*vote=(volatile __attribute__((address_space(3))) unsigned*)((lds_cptr)shm+LDS_VOTE);
    const bool wbad=__any(!(l_reg>=0x1p-80f&&l_reg<=0x1p80f));
    if(lane==0)vote[wid]=wbad?1u:0u;
    asm volatile("s_waitcnt lgkmcnt(0)\n\ts_barrier":::"memory");
    unsigned any_=0u;
    #pragma unroll
    for(int w_=0;w_<NW;++w_)any_|=vote[w_];
    if(__builtin_amdgcn_readfirstlane(any_)!=0u){ asm volatile("s_waitcnt lgkmcnt(0)\n\ts_barrier":::"memory"); return true; }
  }
  if(hi==0)wsf[32+r32]=l_reg;asm volatile("s_waitcnt lgkmcnt(0)":::"memory");
  float rli[16];
  #pragma unroll
  for(int r=0;r<16;++r)rli[r]=__builtin_amdgcn_rcpf(wsf[32+crow(r,hi)]);
  { if(half&&!FAST){ asm volatile("s_waitcnt lgkmcnt(0)\n\ts_barrier":::"memory"); }
    bf16*stg=(bf16*)(shm+(half?LDS_K:LDS_OST))+wid*4096;
    #pragma unroll
    for(int r=0;r<16;++r){const int orow=crow(r,hi);
      #pragma unroll
      for(int d0=0;d0<4;++d0)stg[orow*128+d0*32+r32]=__float2bfloat16(o[d0][r]*rli[r]);}
    if(half){
      asm volatile("s_waitcnt lgkmcnt(0)":::"memory");
      const bf16*stg0=(const bf16*)(shm+LDS_OST)+wid*4096;
      bf16*Ow=O+(rowbase+q0+wid*QBLK)*DM+h*DV; const int ch=lane&15; float gs[8]; float lam_=lam,osc_=osc; asm volatile("":"+v"(lam_),"+v"(osc_));
      #pragma unroll
      for(int i=0;i<8;++i)gs[i]=subg[ch*8+i]*osc_;
      #pragma unroll 2
      for(int i=0;i<8;++i){const int row=i*4+(lane>>4); const u32x4 v0=*(const u32x4*)(stg0+row*128+ch*8), v1=*(const u32x4*)(stg+row*128+ch*8); float x[8]; float ss=0.f;
        #pragma unroll
        for(int q=0;q<4;++q){x[2*q]=__uint_as_float(v0[q]<<16)-lam_*__uint_as_float(v1[q]<<16);x[2*q+1]=__uint_as_float(v0[q]&0xffff0000u)-lam_*__uint_as_float(v1[q]&0xffff0000u);ss+=x[2*q]*x[2*q]+x[2*q+1]*x[2*q+1];}
        ss+=__int_as_float(__builtin_amdgcn_update_dpp(0,__float_as_int(ss),0xB1,0xF,0xF,true)); ss+=__int_as_float(__builtin_amdgcn_update_dpp(0,__float_as_int(ss),0x4E,0xF,0xF,true));
        ss+=__int_as_float(__builtin_amdgcn_update_dpp(0,__float_as_int(ss),0x141,0xF,0xF,true)); ss+=__int_as_float(__builtin_amdgcn_update_dpp(0,__float_as_int(ss),0x140,0xF,0xF,true));
        const float rs=__builtin_amdgcn_rsqf(ss*(1.f/DV)+1e-5f); u32x4 w;
        #pragma unroll
        for(int q=0;q<4;++q)w[q]=cvtpk_s(x[2*q]*rs*gs[2*q],x[2*q+1]*rs*gs[2*q+1]);
        ATTN_STORE16(Ow+(long)row*DM+ch*8,w);}
    } }
  asm volatile("s_waitcnt lgkmcnt(0)\n\ts_barrier":::"memory");
  #undef DMA_K
  #undef DMA_V
  #undef CMASK
  #undef START
  #undef RESC
  #undef ROT
  return false;
}
constexpr int ATTN_LDS_BYTES=LDS_BYTES;
struct AttnTensors { const bf16* Q; const bf16* K; const bf16* V; bf16* O; float lam, osc; const float* subg; };
struct AttnUnit { int b, h, half, qb; };
struct StaticOrder {
  int vcu, G;
  __device__ __forceinline__ explicit StaticOrder(int grid,int vcu_):vcu(vcu_),G(grid){}
  __device__ __forceinline__ bool next(int i,AttnUnit&u)const{ const int idx=vcu+(i>>2)*G; if(idx>=512)return false; const int s=idx&31, x=(idx>>5)&7, ci=idx>>8;
    u.b=x>>2; u.h=(x&3)*2+ci; u.half=i&1; u.qb=(i&2)?63-s:s; return true; }
  __device__ __forceinline__ void a_ready(const AttnUnit&)const{}
  __device__ __forceinline__ void done(const AttnUnit&)const{}
};
template<class Sched,int VAR=0,int THRL=8> __device__ __forceinline__ void attn_phase(char*lds,const AttnTensors&T,const Sched&S,lds_cfptr tball){
  AttnUnit u;
  for(int i=0;S.next(i,u);++i){ S.a_ready(u);
    if(attn_unit<THRL,VAR,true>(u.b,2*u.h+u.half,u.h,u.qb,u.half,T.lam,T.osc,T.subg,T.Q,T.K,T.V,T.O,lds,tball+u.h*TBW))
      attn_unit<THRL,VAR,false>(u.b,2*u.h+u.half,u.h,u.qb,u.half,T.lam,T.osc,T.subg,T.Q,T.K,T.V,T.O,lds,tball+u.h*TBW);
    S.done(u); }
}
#undef SBAR
#undef WAIT_BAR
#undef MFMA32
}

#ifndef PHASES
#define PHASES 0xFFFF
#endif
#ifndef ATTN_PROBE_VAR
#define ATTN_PROBE_VAR 0
#endif
#ifndef REPEAT
#define REPEAT 0x0
#endif
constexpr int NWAVES = 8;
constexpr int BATCH = 2, SEQ = 16384, D = 1024, M = BATCH * SEQ, DEPTH = 2;
constexpr int NH = 8, VD = 128, IN_COLS = 8192, NE = 32, DE = 512;
constexpr float LN_EPS = 1e-5f;
constexpr float DN_ALPHA = 1.4142135623730951f;
constexpr float LOG2E = 1.4426950408889634f;
constexpr int CAP = 32768;
constexpr int MAXROWS = 2 * M + NE * 256;

constexpr size_t MiB = 1u << 20;
constexpr size_t WS_CTL = 0, CTL_ZERO_BYTES = 1 * MiB;
constexpr size_t WS_ROWTOK = 2 * MiB, WS_TOKINFO = 6 * MiB, WS_RIMG = 7 * MiB;
constexpr size_t WS_WIN = 8 * MiB, WS_WAC = 24 * MiB, WS_WOUT2 = 28 * MiB, WS_W13 = 32 * MiB, WS_W2 = 96 * MiB;
constexpr size_t WS_HB = 128 * MiB;
constexpr size_t WS_HB8 = 64 * MiB;
constexpr size_t WS_S0 = 192 * MiB, SLOT = 64 * MiB, WS_END = WS_S0 + 6 * SLOT;
constexpr size_t WS_Q = WS_S0, WS_K = WS_S0 + SLOT, WS_V = WS_S0 + 2 * SLOT, WS_T0 = WS_S0 + 3 * SLOT, WS_T1 = WS_S0 + 4 * SLOT;
constexpr size_t WS_GB = WS_S0, WS_CB = WS_S0 + 2 * SLOT, WS_PB = WS_S0 + 5 * SLOT;
constexpr size_t WS_ON = WS_T0, WS_MC = WS_S0 + 4 * SLOT;
constexpr size_t WS_VB = WS_S0 + 5 * SLOT;
constexpr size_t WS_HID = WS_S0, WS_Y = WS_S0 + 2 * SLOT;
static_assert((size_t)MAXROWS * DE * 2 <= 2 * SLOT && (size_t)MAXROWS * D * 2 <= 4 * SLOT, "MoE buffers");
constexpr int CW_TMO = 0, CW_CODE = 1, CW_BAR = 4096, CW_CNT = 8192;
constexpr int RING_OFF = 0, RING_BYTES = 131072;
constexpr int TB_OFF = 141312;
constexpr int RW_BYTES = 36 * 1024 * 4;
constexpr int MISC_OFF = 151552, LDS_BYTES = 155648;
static_assert(RW_BYTES <= MISC_OFF && TB_OFF + NH * attn_body::TBW * 4 <= MISC_OFF && MISC_OFF + 1024 <= LDS_BYTES && attn_body::LDS_VOTE == MISC_OFF + 1024 && attn_body::LDS_VOTE + 32 <= LDS_BYTES && MISC_OFF + 1088 + (MAXROWS / 256) * 4 <= LDS_BYTES, "LDS map");

#define GAS __attribute__((address_space(1)))
#define LAS __attribute__((address_space(3)))
typedef unsigned short bf16;
typedef unsigned v4u __attribute__((ext_vector_type(4)));
typedef unsigned v2u __attribute__((ext_vector_type(2)));
typedef int v4i __attribute__((ext_vector_type(4)));
typedef float f32x4 __attribute__((ext_vector_type(4)));
typedef float f32x2v __attribute__((ext_vector_type(2)));
typedef GAS unsigned gu32;
#define RLX_AGENT __ATOMIC_RELAXED, __HIP_MEMORY_SCOPE_AGENT
#define LDS_WAIT() asm volatile("s_waitcnt lgkmcnt(0)" ::: "memory")
#define VM_WAIT() asm volatile("s_waitcnt vmcnt(0)" ::: "memory")
__device__ __forceinline__ unsigned f2bf(float f) { unsigned u = __builtin_bit_cast(unsigned, f); return (u + 0x7fffu + ((u >> 16) & 1u)) >> 16; }
__device__ __forceinline__ unsigned pk2(float lo, float hi) { return f2bf(lo) | (f2bf(hi) << 16); }
__device__ __forceinline__ float bflo(unsigned w) { return __uint_as_float(w << 16); }
__device__ __forceinline__ float bfhi(unsigned w) { return __uint_as_float(w & 0xffff0000u); }

#define XB_TMO      128
#define XB_XCNT(j)  (256  + 64 * (j))
#define XB_XSUB(j)  (1280 + 64 * (j))
#define XB_XGEN(j)  (2304 + 64 * (j))
#define XB_TOP      3328
#define XB_TOPGEN   3392
#define XCD_BAR_WORDS 3456
#define XB_SPIN_CAP (1u << 18)

__device__ __forceinline__ unsigned xb_ld(unsigned* p)              { return __hip_atomic_load(p, __ATOMIC_RELAXED, __HIP_MEMORY_SCOPE_AGENT); }
__device__ __forceinline__ unsigned xb_add(unsigned* p, unsigned v) { return __hip_atomic_fetch_add(p, v, __ATOMIC_RELAXED, __HIP_MEMORY_SCOPE_AGENT); }
__device__ __forceinline__ unsigned xb_xcc_id() { return (unsigned)__builtin_amdgcn_s_getreg((3 << 11) | 20) & 0xFu; }
#define XB_SPIN(cond, bar) do { unsigned _sp = 0; while (cond) { __builtin_amdgcn_s_sleep(1); \
    if ((++_sp & 255u) == 0u) { if (xb_ld(&(bar)[XB_TMO])) break; if (_sp > XB_SPIN_CAP) { atomicAdd(&(bar)[XB_TMO], 1u); break; } } } } while (0)

struct XcdBarrier {
    unsigned* bar; unsigned x;
    volatile LAS unsigned* st;
};

__device__ __forceinline__ XcdBarrier xcd_barrier_post(unsigned* bar, volatile LAS unsigned* st) {
    XcdBarrier b; b.bar = bar; b.x = xb_xcc_id(); b.st = st;
    if (threadIdx.x == 0) (void)xb_add(&bar[XB_XCNT(b.x)], 1u);
    return b;
}
__device__ __forceinline__ void xcd_barrier_complete(unsigned* bar, unsigned x, unsigned& nloc, unsigned& nx) {
    const unsigned G = gridDim.x * gridDim.y * gridDim.z;
    unsigned sum, cnt, mine, sp = 0u;
    for (;;) {
        sum = 0u; cnt = 0u; mine = 0u;
#pragma unroll
        for (unsigned j = 0; j < 16; ++j) { const unsigned c = xb_ld(&bar[XB_XCNT(j)]); sum += c; cnt += (c > 0u) ? 1u : 0u; mine = (j == x) ? c : mine; }
        if (sum == G) break;
        __builtin_amdgcn_s_sleep(1);
        if ((++sp & 255u) == 0u) { if (xb_ld(&bar[XB_TMO])) break; if (sp > XB_SPIN_CAP) { atomicAdd(&bar[XB_TMO], 1u); break; } }
    }
    nloc = mine > 0u ? mine : 1u; nx = cnt > 0u ? cnt : 1u;
}

__device__ __forceinline__ void xcd_barrier(const XcdBarrier& b) {
    asm volatile("s_waitcnt vmcnt(0)" ::: "memory");
    __syncthreads();
    if (threadIdx.x == 0) {
        unsigned* bar = b.bar;
        __builtin_amdgcn_s_waitcnt(0);
        unsigned nloc = b.st[0], nx = b.st[1];
        if (nloc == 0u) { xcd_barrier_complete(bar, b.x, nloc, nx); b.st[0] = nloc; b.st[1] = nx; }
        const unsigned old = xb_add(&bar[XB_XSUB(b.x)], 1u);
        const unsigned gen = old / nloc;
        if (old + 1u == (gen + 1u) * nloc) {
            __builtin_amdgcn_fence(__ATOMIC_RELEASE, "agent");
            asm volatile("s_waitcnt vmcnt(0)" ::: "memory");
            const unsigned og = xb_add(&bar[XB_TOP], 1u);
            const unsigned tg = og / nx;
            if (og + 1u == (tg + 1u) * nx) xb_add(&bar[XB_TOPGEN], 1u);
            else XB_SPIN(xb_ld(&bar[XB_TOPGEN]) == tg, bar);
            __builtin_amdgcn_fence(__ATOMIC_ACQUIRE, "agent");
            xb_add(&bar[XB_XGEN(b.x)], 1u);
            asm volatile("s_waitcnt vmcnt(0)" ::: "memory");
        } else {
            XB_SPIN(xb_ld(&bar[XB_XGEN(b.x)]) == gen, bar);
            __builtin_amdgcn_fence(__ATOMIC_ACQUIRE, "agent");
            asm volatile("s_waitcnt vmcnt(0)" ::: "memory");
        }
    }
    __syncthreads();
}

__device__ __forceinline__ float shx(float v, int o, int lane) { return __int_as_float(__builtin_amdgcn_ds_bpermute((lane ^ o) << 2, __float_as_int(v))); }
__device__ __forceinline__ float shi(float v, int idx) { return __int_as_float(__builtin_amdgcn_ds_bpermute(idx << 2, __float_as_int(v))); }
template <int CTRL> __device__ __forceinline__ float dppf(float v) { return __int_as_float(__builtin_amdgcn_update_dpp(0, __float_as_int(v), CTRL, 0xF, 0xF, true)); }
__device__ __forceinline__ float wave_sum(float v, int) {
    v += dppf<0xB1>(v); v += dppf<0x4E>(v); v += dppf<0x141>(v); v += dppf<0x140>(v);
    { auto r = __builtin_amdgcn_permlane16_swap(__float_as_uint(v), __float_as_uint(v), false, false); v = __uint_as_float(r[0]) + __uint_as_float(r[1]); }
    { auto r = __builtin_amdgcn_permlane32_swap(__float_as_uint(v), __float_as_uint(v), false, false); v = __uint_as_float(r[0]) + __uint_as_float(r[1]); }
    return v;
}
__device__ __forceinline__ void transpose_item(const float* Wsrc, int ldw, bf16* dst, int ldd, LAS float* scr, int lane) {
    float t[64];
#pragma unroll
    for (int i = 0; i < 64; ++i) t[i] = __builtin_nontemporal_load(&Wsrc[(size_t)i * ldw + lane]);
#pragma unroll
    for (int i = 0; i < 64; ++i) scr[i * 65 + lane] = t[i];
    LDS_WAIT(); asm volatile("" ::: "memory");
    const int c = lane & 7;
#pragma unroll
    for (int j = 0; j < 8; ++j) { const int n = (lane >> 3) + 8 * j; const LAS float* s = scr + (8 * c) * 65 + n;
        v4u o; o.x = pk2(s[0 * 65], s[1 * 65]); o.y = pk2(s[2 * 65], s[3 * 65]); o.z = pk2(s[4 * 65], s[5 * 65]); o.w = pk2(s[6 * 65], s[7 * 65]);
        ST16_WT(dst + (size_t)n * ldd + 8 * c, o); }
    LDS_WAIT(); asm volatile("" ::: "memory");
}
__device__ __forceinline__ void transpose_item8(const float* Wsrc, int ldw, unsigned char* dst, int ldd, LAS float* scr, int lane) {
    float t[64];
#pragma unroll
    for (int i = 0; i < 64; ++i) t[i] = __builtin_nontemporal_load(&Wsrc[(size_t)i * ldw + lane]);
#pragma unroll
    for (int i = 0; i < 64; ++i) scr[i * 65 + lane] = t[i];
    LDS_WAIT(); asm volatile("" ::: "memory");
    const int c = lane & 3;
#pragma unroll
    for (int j = 0; j < 4; ++j) { const int n = (lane >> 2) + 16 * j; const LAS float* s = scr + (16 * c) * 65 + n; v4u o;
#pragma unroll
        for (int d = 0; d < 4; ++d) { int w = 0;
            w = __builtin_amdgcn_cvt_pk_fp8_f32(s[(4 * d) * 65] * 32.f, s[(4 * d + 1) * 65] * 32.f, w, false); w = __builtin_amdgcn_cvt_pk_fp8_f32(s[(4 * d + 2) * 65] * 32.f, s[(4 * d + 3) * 65] * 32.f, w, true); o[d] = (unsigned)w; }
        ST16_WT(dst + (size_t)n * ldd + 16 * c, o); }
    LDS_WAIT(); asm volatile("" ::: "memory");
}
constexpr int TSCR_BYTES = 64 * 65 * 4;
struct Ptrs {
    const float* in[23]; float* out; unsigned char* ws;
};

__device__ __forceinline__ const void* ld_arg(int i) { asm volatile("" : "+s"(i)); return ((const void* const*)__builtin_amdgcn_kernarg_segment_ptr())[i]; }
#define ARG(i) ((const float*)ld_arg(i))
#define ARG_OUT ((float*)ld_arg(23))
#define ARG_WS ((unsigned char*)ld_arg(24))
__device__ __forceinline__ void convert_weights(int l, LAS float* scr, int gw, int NGW, int lane) {
    const float* w_in = ARG(4) + (size_t)l * D * IN_COLS; const float* w_ap = ARG(8) + (size_t)l * D * D; const float* w_cp = ARG(10) + (size_t)l * D * D; const float* w_out = ARG(11) + (size_t)l * D * D;
    const float* w1 = ARG(18) + (size_t)l * NE * D * DE; const float* w3 = ARG(19) + (size_t)l * NE * D * DE; const float* w2 = ARG(20) + (size_t)l * NE * DE * D;
    bf16* WIN = (bf16*)(ARG_WS + WS_WIN); bf16* WAC = (bf16*)(ARG_WS + WS_WAC); bf16* WOUT2 = (bf16*)(ARG_WS + WS_WOUT2); bf16* W13 = (bf16*)(ARG_WS + WS_W13); bf16* W2 = (bf16*)(ARG_WS + WS_W2);
    constexpr int I_IN = 16 * 128, I_SQ = 16 * 16, I_E13 = 16 * 8, I_E2 = 8 * 16;
    constexpr int NITEMS = I_IN + 3 * I_SQ + NE * (2 * I_E13 + I_E2);
    for (int it = gw; it < NITEMS; it += NGW) {
        int r = it;
        if (r < I_IN) { const int kb = r / 128, nb = r % 128, n0 = nb * 64, k0 = kb * 64; int dr = n0;
            if (n0 >= 4096 && n0 < 5120) { const int c = n0 - 4096; dr = 4096 + (c / 128) * 256 + (c % 128); }
            else if (n0 >= 5120 && n0 < 6144) { const int c = n0 - 5120; dr = 4096 + (c / 128) * 256 + 128 + (c % 128); }
            if (dr < 3072) transpose_item8(w_in + (size_t)k0 * IN_COLS + n0, IN_COLS, (unsigned char*)WIN + (size_t)dr * D + k0, D, scr, lane);
            else if (dr >= 6144) transpose_item8(w_in + (size_t)k0 * IN_COLS + n0, IN_COLS, (unsigned char*)WIN + (size_t)6144 * D * 2 + (size_t)(dr - 6144) * D + k0, D, scr, lane);
            else transpose_item(w_in + (size_t)k0 * IN_COLS + n0, IN_COLS, WIN + (size_t)dr * D + k0, D, scr, lane);
            continue; } r -= I_IN;
        if (r < I_SQ) { const int kb = r / 16, nb = r % 16; transpose_item(w_ap + (size_t)kb * 64 * D + nb * 64, D, WAC + (size_t)(nb * 64) * D + kb * 64, D, scr, lane); continue; } r -= I_SQ;
        if (r < I_SQ) { const int kb = r / 16, nb = r % 16; transpose_item(w_cp + (size_t)kb * 64 * D + nb * 64, D, WAC + (size_t)(D + nb * 64) * D + kb * 64, D, scr, lane); continue; } r -= I_SQ;
        if (r < I_SQ) { const int kb = r / 16, nb = r % 16; transpose_item(w_out + (size_t)kb * 64 * D + nb * 64, D, WOUT2 + (size_t)(nb * 64) * D + kb * 64, D, scr, lane); continue; } r -= I_SQ;
        const int e = r / (2 * I_E13 + I_E2); r -= e * (2 * I_E13 + I_E2);
        if (r < 2 * I_E13) { const int which = r / I_E13; r -= which * I_E13; const int kb = r / 8, nb = r % 8, n0 = nb * 64;
            const float* src = (which ? w3 : w1) + (size_t)e * D * DE + (size_t)kb * 64 * DE + n0; const int dr = (n0 / 128) * 256 + which * 128 + (n0 % 128);
            transpose_item8(src, DE, (unsigned char*)W13 + ((size_t)e * D + dr) * D + kb * 64, D, scr, lane); continue; } r -= 2 * I_E13;
        { const int kb = r / 16, nb = r % 16; transpose_item8(w2 + (size_t)e * DE * D + (size_t)kb * 64 * D + nb * 64, D, (unsigned char*)W2 + ((size_t)e * D + nb * 64) * DE + kb * 64, DE, scr, lane); }
    }
}
__device__ __forceinline__ int rcol(int j, int lane) { return (j >> 1) * 512 + 8 * lane + (j & 1) * 4; }
__device__ __forceinline__ void load_row_bf16(const bf16* row, f32x4 (&v)[4], int lane) {
    const v4u a = *(const v4u*)(row + 8 * lane), b = *(const v4u*)(row + 512 + 8 * lane);
    v[0] = (f32x4){bflo(a.x), bfhi(a.x), bflo(a.y), bfhi(a.y)}; v[1] = (f32x4){bflo(a.z), bfhi(a.z), bflo(a.w), bfhi(a.w)};
    v[2] = (f32x4){bflo(b.x), bfhi(b.x), bflo(b.y), bfhi(b.y)}; v[3] = (f32x4){bflo(b.z), bfhi(b.z), bflo(b.w), bfhi(b.w)};
}
__device__ __forceinline__ void load_row_fp8(const unsigned char* row, f32x4 (&v)[4], int lane) {
    typedef unsigned u2_ __attribute__((ext_vector_type(2))); typedef float f2_ __attribute__((ext_vector_type(2)));
    const u2_ a = *(const u2_*)(row + 8 * lane), b = *(const u2_*)(row + 512 + 8 * lane);
    { const f2_ p = __builtin_amdgcn_cvt_pk_f32_fp8((int)a.x, false), q = __builtin_amdgcn_cvt_pk_f32_fp8((int)a.x, true); v[0] = (f32x4){p.x, p.y, q.x, q.y}; }
    { const f2_ p = __builtin_amdgcn_cvt_pk_f32_fp8((int)a.y, false), q = __builtin_amdgcn_cvt_pk_f32_fp8((int)a.y, true); v[1] = (f32x4){p.x, p.y, q.x, q.y}; }
    { const f2_ p = __builtin_amdgcn_cvt_pk_f32_fp8((int)b.x, false), q = __builtin_amdgcn_cvt_pk_f32_fp8((int)b.x, true); v[2] = (f32x4){p.x, p.y, q.x, q.y}; }
    { const f2_ p = __builtin_amdgcn_cvt_pk_f32_fp8((int)b.y, false), q = __builtin_amdgcn_cvt_pk_f32_fp8((int)b.y, true); v[3] = (f32x4){p.x, p.y, q.x, q.y}; }
}
__device__ __forceinline__ void load_row_f32(const float* row, f32x4 (&v)[4], int lane) {
#pragma unroll
    for (int j = 0; j < 4; ++j) v[j] = __builtin_nontemporal_load((const f32x4*)(row + rcol(j, lane)));
}
__device__ __forceinline__ void store_row_bf16(bf16* row, const f32x4 (&v)[4], int lane) {
    v4u a, b; a.x = pk2(v[0].x, v[0].y); a.y = pk2(v[0].z, v[0].w); a.z = pk2(v[1].x, v[1].y); a.w = pk2(v[1].z, v[1].w);
    b.x = pk2(v[2].x, v[2].y); b.y = pk2(v[2].z, v[2].w); b.z = pk2(v[3].x, v[3].y); b.w = pk2(v[3].z, v[3].w);
    ST16_WT(row + 8 * lane, a); ST16_WT(row + 512 + 8 * lane, b);
}
__device__ __forceinline__ void store_row_fp8(unsigned char* row, const f32x4 (&v)[4], int lane) {
    typedef unsigned u2_ __attribute__((ext_vector_type(2)));
    int a0 = 0, a1 = 0, b0 = 0, b1 = 0;
    a0 = __builtin_amdgcn_cvt_pk_fp8_f32(v[0].x, v[0].y, a0, false); a0 = __builtin_amdgcn_cvt_pk_fp8_f32(v[0].z, v[0].w, a0, true);
    a1 = __builtin_amdgcn_cvt_pk_fp8_f32(v[1].x, v[1].y, a1, false); a1 = __builtin_amdgcn_cvt_pk_fp8_f32(v[1].z, v[1].w, a1, true);
    b0 = __builtin_amdgcn_cvt_pk_fp8_f32(v[2].x, v[2].y, b0, false); b0 = __builtin_amdgcn_cvt_pk_fp8_f32(v[2].z, v[2].w, b0, true);
    b1 = __builtin_amdgcn_cvt_pk_fp8_f32(v[3].x, v[3].y, b1, false); b1 = __builtin_amdgcn_cvt_pk_fp8_f32(v[3].z, v[3].w, b1, true);
    const u2_ a = {(unsigned)a0, (unsigned)a1}, b = {(unsigned)b0, (unsigned)b1};
    ST8_WT(row + 8 * lane, a); ST8_WT(row + 512 + 8 * lane, b);
}
__device__ __forceinline__ void store_row_f32(float* row, const f32x4 (&v)[4], int lane) {
#pragma unroll
    for (int j = 0; j < 4; ++j) __builtin_nontemporal_store(v[j], (f32x4*)(row + rcol(j, lane)));
}
__device__ __forceinline__ void ln16(f32x4 (&v)[4], const float* g, const float* b, int lane) {
    float s = 0.f;
#pragma unroll
    for (int j = 0; j < 4; ++j) s += (v[j].x + v[j].y) + (v[j].z + v[j].w);
    const float mean = wave_sum(s, lane) * (1.f / D); float s2 = 0.f;
#pragma unroll
    for (int j = 0; j < 4; ++j) { v[j] = v[j] - mean; s2 += (v[j].x * v[j].x + v[j].y * v[j].y) + (v[j].z * v[j].z + v[j].w * v[j].w); }
    const float rstd = 1.f / sqrtf(wave_sum(s2, lane) * (1.f / D) + LN_EPS);
#pragma unroll
    for (int j = 0; j < 4; ++j) { const f32x4 gv = *(const f32x4*)(g + rcol(j, lane)), bv = *(const f32x4*)(b + rcol(j, lane)); v[j] = v[j] * rstd * gv + bv; }
}
__device__ __forceinline__ int t5_bucket(int n) {
    if (n < 16) return n;
    const float nf = (float)n; int large = 16 + (int)(logf(nf / 16.0f) / 2.0794415416798357f * 16.0f);
    return large < 31 ? large : 31;
}

#define PHASE_PTRS unsigned char* ws = ARG_WS; float* out = ARG_OUT; bf16* HB = (bf16*)(ws + WS_HB); int* rowtok = (int*)(ws + WS_ROWTOK); v4i* tokinfo = (v4i*)(ws + WS_TOKINFO); gu32* ctl = (gu32*)(ws + WS_CTL); \
    (void)out; (void)HB; (void)rowtok; (void)tokinfo; (void)ctl; \
    int tidp_ = tid; asm volatile("" : "+v"(tidp_)); const int tidl = tidp_, lanel = tidp_ & 63; (void)tidl; (void)lanel
__device__ __forceinline__ int launder_i(int v) { asm volatile("" : "+s"(v)); return v; }
__global__ void __launch_bounds__(NWAVES * 64, 2) hybrid_fwd(Ptrs P) {
    extern __shared__ __attribute__((aligned(16))) unsigned char lds[];
    LAS unsigned char* L = (LAS unsigned char*)lds;
    volatile LAS unsigned* MISC = (volatile LAS unsigned*)(L + MISC_OFF);
    LAS int* TP = (LAS int*)(L + MISC_OFF + 128);
    LAS int* CN = (LAS int*)(L + MISC_OFF + 128 + 256);
    LAS int* TT = (LAS int*)(L + MISC_OFF + 1088);
    const int tid = threadIdx.x, lane = tid & 63, wave = __builtin_amdgcn_readfirstlane(tid >> 6);
    const int G = gridDim.x; int vcu; { const int bx = blockIdx.x; vcu = (G % 8 == 0) ? (bx % 8) * (G / 8) + bx / 8 : bx; }
    const int gw = vcu * NWAVES + wave, NGW = G * NWAVES;
    unsigned char* ws = ARG_WS;
    gu32* ctl = (gu32*)(ws + WS_CTL);
    for (int u = tid; u < (LDS_BYTES - MISC_OFF) / 4; u += NWAVES * 64) ((LAS unsigned*)(L + MISC_OFF))[u] = 0u;
    __syncthreads();
    XcdBarrier bar = xcd_barrier_post((unsigned*)(ctl + CW_BAR), MISC + 8);
#define GRID_BAR() do { XcdBarrier b_ = bar; asm volatile("" : "+s"(b_.x), "+s"(b_.bar)); xcd_barrier(b_); } while (0)

    float* out = ARG_OUT;
    bf16* HB = (bf16*)(ws + WS_HB);
    int* rowtok = (int*)(ws + WS_ROWTOK); v4i* tokinfo = (v4i*)(ws + WS_TOKINFO);

    if constexpr ((PHASES >> 0) & 1) _Pragma("unroll 1") for (int rep_ = 0, nrep_ = launder_i(1 + ((REPEAT >> 0) & 1)); rep_ < nrep_; ++rep_) {
        LAS float* scr = (LAS float*)(L + RING_OFF + wave * TSCR_BYTES);
        convert_weights(0, scr, gw, NGW, lane);
        const float* x = ARG(0);
        { float* img = (float*)(ws + WS_RIMG); const float* wrg = ARG(14); const float* wre = ARG(16);
#define WLIDX(o, k) ((((o) * 4 + (((k) >> 9) * 2 + (((k) & 7) >> 2))) * 64 + (((k) & 511) >> 3)) * 4 + ((k) & 3))
          for (int i = (int)blockIdx.x * (NWAVES * 64) + tid; i < DEPTH * 36 * D; i += G * NWAVES * 64) { const int ll = i / (36 * D), r = i - ll * (36 * D), o = r >> 10, k = r & (D - 1);
              img[ll * 36 * D + WLIDX(o, k)] = (o < 4) ? wrg[(size_t)ll * D * 4 + k * 4 + o] : wre[(size_t)ll * D * NE + k * NE + (o - 4)]; }
#undef WLIDX
        }
        { const float* g0 = ARG(1); const float* b0 = ARG(2);
        for (int m = gw; m < M; m += 4 * NGW) { f32x4 v[4], w[4], x2[4], x3[4];
            load_row_f32(x + (size_t)m * D, v, lane); load_row_f32(x + (size_t)(m + NGW) * D, w, lane); load_row_f32(x + (size_t)(m + 2 * NGW) * D, x2, lane); load_row_f32(x + (size_t)(m + 3 * NGW) * D, x3, lane);
            ln16(v, g0, b0, lane); ln16(w, g0, b0, lane); ln16(x2, g0, b0, lane); ln16(x3, g0, b0, lane);
            store_row_bf16(HB + (size_t)m * D, v, lane); store_row_bf16(HB + (size_t)(m + NGW) * D, w, lane); store_row_bf16(HB + (size_t)(m + 2 * NGW) * D, x2, lane); store_row_bf16(HB + (size_t)(m + 3 * NGW) * D, x3, lane);
            { unsigned char* h8 = ws + WS_HB8;
              store_row_fp8(h8 + (size_t)m * D, v, lane); store_row_fp8(h8 + (size_t)(m + NGW) * D, w, lane); store_row_fp8(h8 + (size_t)(m + 2 * NGW) * D, x2, lane); store_row_fp8(h8 + (size_t)(m + 3 * NGW) * D, x3, lane); } } }
        GRID_BAR();
    }

#pragma unroll 1
    for (int l = 0; l < DEPTH; ++l) {
        const float lam_init = __int_as_float(launder_i((l == 0) ? 0x3e4ccccd : 0x3eb60549));
        int Gl = G, vcul = vcu, bxl = (int)blockIdx.x; asm volatile("" : "+s"(Gl), "+s"(vcul), "+s"(bxl));
        int tidl = tid; asm volatile("" : "+v"(tidl)); const int lanel = tidl & 63; const int gwl = vcul * NWAVES + wave, NGWl = Gl * NWAVES;
        if constexpr ((PHASES >> 1) & 1) _Pragma("unroll 1") for (int rep_ = 0, nrep_ = launder_i(1 + ((REPEAT >> 1) & 1)); rep_ < nrep_; ++rep_) {
            PHASE_PTRS;
            pg8::ProbDense8<512> pr{(const bf16*)(ws + WS_HB8), (const bf16*)(ws + WS_WIN)}; pg8::StaticOrder S; S.init(M, 3072, Gl, bxl);
            pg8::EpiQKV E{(bf16*)(ws + WS_Q), SLOT / 2, attn_body::C2};
            pg8::gemm_phase<pg8::EpiQKV, pg8::ProbDense8<512>, pg8::StaticOrder>(L + RING_OFF, pr, S, E);
            GRID_BAR();
        }
        if constexpr ((PHASES >> 2) & 1) _Pragma("unroll 1") for (int rep_ = 0, nrep_ = launder_i(1 + ((REPEAT >> 2) & 1)); rep_ < nrep_; ++rep_) {
            PHASE_PTRS;
            LAS float* tb = (LAS float*)(L + TB_OFF); const float* rel = ARG(3);
            { constexpr int NT_ = NH * attn_body::TBW / (NWAVES * 64); static_assert(NT_ * NWAVES * 64 == NH * attn_body::TBW, "bias table"); float va[NT_], vb[NT_];
              _Pragma("unroll") for (int k_ = 0; k_ < NT_; ++k_) { const int i = tidl + k_ * NWAVES * 64, h = i / attn_body::TBW, d = i - h * attn_body::TBW - attn_body::TBP, dd = (d >= 0 && d < 128) ? d : 0;
                  va[k_] = rel[t5_bucket(dd) * NH + h]; vb[k_] = rel[31 * NH + h]; }
              _Pragma("unroll") for (int k_ = 0; k_ < NT_; ++k_) { const int i = tidl + k_ * NWAVES * 64, h = i / attn_body::TBW, d = i - h * attn_body::TBW - attn_body::TBP;
                  tb[i] = d < 0 ? -INFINITY : d < 128 ? (va[k_] - vb[k_]) * LOG2E : 0.f; } }
            __syncthreads();
            const float* lv = ARG(6) + (size_t)l * 4 * 64;
            const float lam = __int_as_float(__builtin_amdgcn_readfirstlane(__float_as_int(expf(wave_sum(lv[lanel] * lv[64 + lanel], lanel)) - expf(wave_sum(lv[128 + lanel] * lv[192 + lanel], lanel)) + lam_init)));
            const attn_body::AttnTensors AT{(const attn_body::bf16*)(ws + WS_Q), (const attn_body::bf16*)(ws + WS_K), (const attn_body::bf16*)(ws + WS_V), (attn_body::bf16*)(ws + WS_ON), lam, __int_as_float(launder_i((l == 0) ? 0x3f4ccccd : 0x3f24fd5c))  , ARG(7) + (size_t)l * VD};
            const attn_body::StaticOrder S(Gl, vcul);
#if ATTN_PROBE_VAR
            if (rep_ > 0) { attn_body::AttnTensors AT2 = AT; AT2.O = (attn_body::bf16*)(ws + WS_S0 + 4 * SLOT);
                attn_body::attn_phase<attn_body::StaticOrder, ATTN_PROBE_VAR>((char*)lds + RING_OFF, AT2, S, (attn_body::lds_cfptr)tb); }
            else
#endif
            attn_body::attn_phase<attn_body::StaticOrder>((char*)lds + RING_OFF, AT, S, (attn_body::lds_cfptr)tb);
            GRID_BAR();
        }
        if constexpr ((PHASES >> 3) & 1) _Pragma("unroll 1") for (int rep_ = 0, nrep_ = launder_i(1 + ((REPEAT >> 3) & 1)); rep_ < nrep_; ++rep_) {
            PHASE_PTRS;
            pg8::EpiConvGate E{(bf16*)(ws + WS_CB), (bf16*)(ws + WS_PB), (unsigned char*)(ws + WS_GB), ARG(5) + (size_t)l * 2 * D};
            { pg8::ProbDense<1024> pr{HB, (const bf16*)(ws + WS_WIN) + (size_t)3072 * D}; pg8::StaticOrder S; S.init(M, 3072, Gl, bxl);
              pg8::gemm_phase<pg8::EpiConvGate, pg8::ProbDense<1024>, pg8::StaticOrder>(L + RING_OFF, pr, S, E); }
            GRID_BAR();
        }
        if constexpr ((PHASES >> 4) & 1) _Pragma("unroll 1") for (int rep_ = 0, nrep_ = launder_i(1 + ((REPEAT >> 4) & 1)); rep_ < nrep_; ++rep_) {
            PHASE_PTRS;
            const bool split = Gl >= 32; const int NC4 = split ? ((Gl * 5 / 16) & ~7) : Gl;
            if (bxl < NC4) {
                const bf16* PB = (const bf16*)(ws + WS_PB); bf16* CB = (bf16*)(ws + WS_CB);
                const float* cw = ARG(9) + (size_t)l * 3 * D;
                bf16* UD = rep_ ? (bf16*)(ws + WS_T1) : CB;
                for (int it = bxl * NWAVES + wave; it < (M / 16) * 2; it += NC4 * NWAVES) { const int row0 = (it >> 1) * 16, c = it & 1; const bool head = (row0 & (SEQ - 1)) == 0;
                    float w[3][8];
#pragma unroll
                    for (int j = 0; j < 3; ++j)
#pragma unroll
                        for (int i = 0; i < 8; ++i) w[j][i] = cw[j * D + c * 512 + 8 * lanel + i];
                    const size_t off0 = (size_t)row0 * D + c * 512 + 8 * lanel;
                    v4u q[6]; q[0] = (v4u){0u, 0u, 0u, 0u}; q[1] = (v4u){0u, 0u, 0u, 0u};
                    if (!head) { q[0] = *(const v4u*)(PB + off0 - 2 * D); q[1] = *(const v4u*)(PB + off0 - D); }
#pragma unroll
                    for (int i = 0; i < 16; i += 4) { v4u cbv[4];
#pragma unroll
                        for (int j = 0; j < 4; ++j) { q[2 + j] = *(const v4u*)(PB + off0 + (size_t)(i + j) * D); cbv[j] = *(const v4u*)(CB + off0 + (size_t)(i + j) * D); }
#pragma unroll
                        for (int j = 0; j < 4; ++j) { v4u o;
#pragma unroll
                            for (int e = 0; e < 4; ++e) {
                                const float lo = bflo(cbv[j][e]) * (w[0][2 * e] * bflo(q[j][e]) + w[1][2 * e] * bflo(q[j + 1][e]) + w[2][2 * e] * bflo(q[j + 2][e]));
                                const float hi = bfhi(cbv[j][e]) * (w[0][2 * e + 1] * bfhi(q[j][e]) + w[1][2 * e + 1] * bfhi(q[j + 1][e]) + w[2][2 * e + 1] * bfhi(q[j + 2][e]));
                                o[e] = pk2(lo, hi); }
                            ST16_WT(UD + off0 + (size_t)(i + j) * D, o); }
                        q[0] = q[4]; q[1] = q[5]; } }
            }
            if (!split || bxl >= NC4) {
                pg8::EpiConvGate E{(bf16*)(ws + WS_CB), (bf16*)(ws + WS_PB), (unsigned char*)(ws + WS_GB), ARG(5) + (size_t)l * 2 * D};
                pg8::ProbDense8<512> pr{(const bf16*)(ws + WS_HB8), (const bf16*)(ws + WS_WIN) + (size_t)6144 * D}; pg8::StaticOrder S; S.init(M, 2048, split ? Gl - NC4 : Gl, split ? bxl - NC4 : bxl);
                pg8::EpiGateOnly E2{E};
                pg8::gemm_phase<pg8::EpiGateOnly, pg8::ProbDense8<512>, pg8::StaticOrder>(L + RING_OFF, pr, S, E2);
            }
            GRID_BAR();
        }
        if constexpr ((PHASES >> 5) & 1) _Pragma("unroll 1") for (int rep_ = 0, nrep_ = launder_i(1 + ((REPEAT >> 5) & 1)); rep_ < nrep_; ++rep_) {
            PHASE_PTRS;
            pg8::ProbDual<1024> pr{(const bf16*)(ws + WS_ON), (const bf16*)(ws + WS_CB), (const bf16*)(ws + WS_WAC)}; pg8::DualOrder S; S.S.init(M, 1024, Gl, bxl);
            pg8::EpiDual E{(bf16*)(ws + WS_MC), (const unsigned char*)(ws + WS_GB)};
            pg8::gemm_phase<pg8::EpiDual, pg8::ProbDual<1024>, pg8::DualOrder>(L + RING_OFF, pr, S, E);
            GRID_BAR();
        }
        if constexpr ((PHASES >> 6) & 1) _Pragma("unroll 1") for (int rep_ = 0, nrep_ = launder_i(1 + ((REPEAT >> 6) & 1)); rep_ < nrep_; ++rep_) {
            PHASE_PTRS;
            pg8::ProbDense<1024> pr{(const bf16*)(ws + WS_MC), (const bf16*)(ws + WS_WOUT2)}; pg8::StaticOrder S; S.init(M, 1024, Gl, bxl);
            pg8::EpiResid E{HB, (bf16*)(ws + WS_VB), DN_ALPHA};
            pg8::gemm_phase<pg8::EpiResid, pg8::ProbDense<1024>, pg8::StaticOrder>(L + RING_OFF, pr, S, E);
            GRID_BAR();
        }
        if constexpr ((PHASES >> 7) & 1) _Pragma("unroll 1") for (int rep_ = 0, nrep_ = launder_i(1 + ((REPEAT >> 7) & 1)); rep_ < nrep_; ++rep_) {
            PHASE_PTRS;
            LAS float* WL = (LAS float*)L;
            { const f32x4* img = (const f32x4*)(ws + WS_RIMG + (size_t)l * RW_BYTES);
              constexpr int NI = RW_BYTES / 16 / (NWAVES * 64); static_assert(NI * NWAVES * 64 * 16 == RW_BYTES, "router image"); f32x4 t[NI];
              _Pragma("unroll") for (int i = 0; i < NI; ++i) t[i] = img[tidl + i * NWAVES * 64];
              _Pragma("unroll") for (int i = 0; i < NI; ++i) ((LAS f32x4*)WL)[tidl + i * NWAVES * 64] = t[i]; }
            __syncthreads();
            const float* brg = ARG(15) + l * 4; const float* bre = ARG(17) + l * NE;
            const float* g1 = ARG(12) + (size_t)l * D; const float* b1 = ARG(13) + (size_t)l * D;
            gu32* cnt = ctl + CW_CNT + l * NE * 64; bf16* hb_dst = HB; int* rt_dst = rowtok; v4i* ti_dst = tokinfo; const bf16* VB = (const bf16*)(ws + WS_VB);
            if (rep_ > 0) { cnt = ctl + CW_CNT + (2 + l) * NE * 64; hb_dst = (bf16*)(ws + WS_S0 + 2 * SLOT); rt_dst = (int*)(ws + WS_S0 + 3 * SLOT); ti_dst = (v4i*)(ws + WS_S0 + 4 * SLOT); }
            int E0 = 0, E1 = 0; float G0 = 0.f, G1 = 0.f; int k = 0;
#define BFLY(v, n, mask) _Pragma("unroll") for (int i_ = 0; i_ < (n); ++i_) { const bool up_ = (lanel & (mask)) != 0; const float send_ = up_ ? v[i_] : v[i_ + (n)], keep_ = up_ ? v[i_ + (n)] : v[i_]; v[i_] = keep_ + XLANE(send_, mask); }
#define XLANE(x_, mask) ((mask) == 32 ? ({ auto r_ = __builtin_amdgcn_permlane32_swap(__float_as_uint(x_), __float_as_uint(x_), false, false); __uint_as_float((lanel & 32) ? r_[0] : r_[1]); }) \
                       : (mask) == 16 ? ({ auto r_ = __builtin_amdgcn_permlane16_swap(__float_as_uint(x_), __float_as_uint(x_), false, false); __uint_as_float((lanel & 16) ? r_[0] : r_[1]); }) \
                       : dppf<0x128>(x_))
#define RDOT(row_, col) ({ f32x2v a_ = {0.f, 0.f}; _Pragma("unroll") for (int j_ = 0; j_ < 4; ++j_) { const f32x4 wv_ = *(const LAS f32x4*)(WL + (((col) * 4 + j_) * 64 + lanel) * 4); \
                a_ = __builtin_elementwise_fma(row_[j_].xy, wv_.xy, a_); a_ = __builtin_elementwise_fma(row_[j_].zw, wv_.zw, a_); } a_.x + a_.y; })
#define ROUTE_TOKEN(row_, kk) do { float pg[4]; \
                _Pragma("unroll") for (int o = 0; o < 4; ++o) pg[o] = RDOT(row_, o); \
                BFLY(pg, 2, 32); BFLY(pg, 1, 16); \
                pg[0] += dppf<0xB1>(pg[0]); pg[0] += dppf<0x4E>(pg[0]); pg[0] += dppf<0x141>(pg[0]); pg[0] += dppf<0x140>(pg[0]);        \
                const float gv = pg[0] + brg[lanel >> 4]; float lg[4];                            \
                _Pragma("unroll") for (int j = 0; j < 4; ++j) lg[j] = __int_as_float(__builtin_amdgcn_readlane(__float_as_int(gv), 16 * j)); \
                int gi = 0; float gm = lg[0]; \
                _Pragma("unroll") for (int j = 1; j < 4; ++j) if (lg[j] > gm) { gm = lg[j]; gi = j; } \
                float gs = 0.f; \
                _Pragma("unroll") for (int j = 0; j < 4; ++j) gs += __builtin_amdgcn_exp2f((lg[j] - gm) * LOG2E); \
                asm volatile("" : "+v"(gs)); \
                const float gp = __builtin_amdgcn_rcpf(gs); \
                const int gis = __builtin_amdgcn_readfirstlane(gi); float pe[8];                    \
                _Pragma("unroll") for (int j = 0; j < 8; ++j) pe[j] = RDOT(row_, 4 + 8 * gis + j); \
                BFLY(pe, 4, 32); BFLY(pe, 2, 16); BFLY(pe, 1, 8); \
                pe[0] += dppf<0xB1>(pe[0]); pe[0] += dppf<0x4E>(pe[0]); pe[0] += dppf<0x141>(pe[0]);                                     \
                const float ev = pe[0] + bre[8 * gis + (lanel >> 3)]; float le[8];                 \
                _Pragma("unroll") for (int j = 0; j < 8; ++j) le[j] = __int_as_float(__builtin_amdgcn_readlane(__float_as_int(ev), 8 * j)); \
                int i1 = 0; float m1 = le[0]; \
                _Pragma("unroll") for (int j = 1; j < 8; ++j) if (le[j] > m1) { m1 = le[j]; i1 = j; } \
                int i2 = -1; float m2 = -INFINITY; \
                _Pragma("unroll") for (int j = 0; j < 8; ++j) if (j != i1 && le[j] > m2) { m2 = le[j]; i2 = j; } \
                const float r = __builtin_amdgcn_exp2f((m2 - m1) * LOG2E), den = __builtin_amdgcn_rcpf(1.f + r); \
                if (lanel == (kk)) { E0 = gis * 8 + i1; E1 = gis * 8 + i2; G0 = gp * den; G1 = gp * r * den; } } while (0)
            for (int m = gwl; m < M; m += 4 * NGWl, k += 4) { f32x4 v[4], w[4], x2[4], x3[4];
                load_row_bf16(VB + (size_t)m * D, v, lanel); load_row_bf16(VB + (size_t)(m + NGWl) * D, w, lanel);
                load_row_bf16(VB + (size_t)(m + 2 * NGWl) * D, x2, lanel); load_row_bf16(VB + (size_t)(m + 3 * NGWl) * D, x3, lanel);
                ln16(v, g1, b1, lanel); ln16(w, g1, b1, lanel); ln16(x2, g1, b1, lanel); ln16(x3, g1, b1, lanel);
                store_row_bf16(hb_dst + (size_t)m * D, v, lanel); store_row_bf16(hb_dst + (size_t)(m + NGWl) * D, w, lanel);
                store_row_bf16(hb_dst + (size_t)(m + 2 * NGWl) * D, x2, lanel); store_row_bf16(hb_dst + (size_t)(m + 3 * NGWl) * D, x3, lanel);
                { unsigned char* h8 = ws + WS_HB8;
                  store_row_fp8(h8 + (size_t)m * D, v, lanel); store_row_fp8(h8 + (size_t)(m + NGWl) * D, w, lanel); store_row_fp8(h8 + (size_t)(m + 2 * NGWl) * D, x2, lanel); store_row_fp8(h8 + (size_t)(m + 3 * NGWl) * D, x3, lanel); }
                ROUTE_TOKEN(v, k); ROUTE_TOKEN(w, k + 1); ROUTE_TOKEN(x2, k + 2); ROUTE_TOKEN(x3, k + 3);
            }
#undef BFLY
#undef XLANE
#undef RDOT
#undef ROUTE_TOKEN
            LAS unsigned* HIST = (LAS unsigned*)(L + MISC_OFF + 512); LAS unsigned* BASE = (LAS unsigned*)(L + MISC_OFF + 640);
            if (tidl < NE) HIST[tidl] = 0u;
            __syncthreads();
            unsigned p0 = 0u, p1 = 0u;
            if (lanel < k) { p0 = __hip_atomic_fetch_add(HIST + E0, 1u, __ATOMIC_RELAXED, __HIP_MEMORY_SCOPE_WORKGROUP); p1 = __hip_atomic_fetch_add(HIST + E1, 1u, __ATOMIC_RELAXED, __HIP_MEMORY_SCOPE_WORKGROUP); }
            __syncthreads();
            if (tidl < NE) { const unsigned c = HIST[tidl]; BASE[tidl] = c ? __hip_atomic_fetch_add(cnt + tidl * 64, c, RLX_AGENT) : 0u; }
            __syncthreads();
            if (lanel < k) { const int tok = gwl + lanel * NGWl;
                p0 += BASE[E0]; p1 += BASE[E1];
                rt_dst[(size_t)E0 * CAP + p0] = tok; rt_dst[(size_t)E1 * CAP + p1] = tok;
                ti_dst[tok] = (v4i){(int)(E0 * CAP + p0), (int)(E1 * CAP + p1), __float_as_int(G0), __float_as_int(G1)}; }
            GRID_BAR();
        }
        {
            PHASE_PTRS;
            gu32* cnt = ctl + CW_CNT + l * NE * 64;
            if (tidl < NE) CN[tidl] = (int)__hip_atomic_load(cnt + tidl * 64, RLX_AGENT);
            __syncthreads();
            if (tidl == 0) { int a = 0; for (int e = 0; e < NE; ++e) { TP[e] = a; a += (CN[e] + 255) >> 8; } TP[NE] = a; }
            if (tidl < NE) { const int e = tidl; int fb = 0, c1b = 0, c2b = 0, F = 0, C1 = 0;
                for (int j = 0; j < NE; ++j) { const int cj = CN[j], fj = cj >> 8, rj = cj & 255, is1 = rj > 128, is2 = (rj > 0 && rj <= 128); F += fj; C1 += is1; if (j < e) { fb += fj; c1b += is1; c2b += is2; } }
                const int cn = CN[e], nf = cn >> 8, r = cn & 255;
                for (int t = 0; t < nf; ++t) TT[fb + t] = (e << 16) | t;
                if (r > 128) TT[F + c1b] = (e << 16) | nf; else if (r > 0) TT[F + C1 + c2b] = (e << 16) | nf; }
            __syncthreads();
        }
        if constexpr ((PHASES >> 8) & 1) _Pragma("unroll 1") for (int rep_ = 0, nrep_ = launder_i(1 + ((REPEAT >> 8) & 1)); rep_ < nrep_; ++rep_) {
            PHASE_PTRS;
            pg8::ProbMoe<512, 4, true, true> pr{(const bf16*)(ws + WS_HB8), (const bf16*)(ws + WS_W13), rowtok, CAP}; pg8::MoeOrder S{TP, CN, TT, 4, Gl, vcul};
            pg8::EpiSilu8 E{ws + WS_HID};
            pg8::gemm_phase<pg8::EpiSilu8, pg8::ProbMoe<512, 4, true, true>, pg8::MoeOrder>(L + RING_OFF, pr, S, E);
            GRID_BAR();
        }
        if constexpr ((PHASES >> 9) & 1) _Pragma("unroll 1") for (int rep_ = 0, nrep_ = launder_i(1 + ((REPEAT >> 9) & 1)); rep_ < nrep_; ++rep_) {
            PHASE_PTRS;
            pg8::ProbMoe<256, 4, false, true> pr{(const bf16*)(ws + WS_HID), (const bf16*)(ws + WS_W2), rowtok, CAP}; pg8::MoeOrder S{TP, CN, TT, 4, Gl, vcul};
            pg8::EpiOut8 E{ws + WS_Y};
            pg8::gemm_phase<pg8::EpiOut8, pg8::ProbMoe<256, 4, false, true>, pg8::MoeOrder>(L + RING_OFF, pr, S, E);
            GRID_BAR();
        }
        if constexpr ((PHASES >> 10) & 1) {
            PHASE_PTRS;
            _Pragma("unroll 1") for (int rep_ = 0, nrep_ = launder_i(1 + ((REPEAT >> 10) & 1)); rep_ < nrep_; ++rep_) {
            const unsigned char* Y = ws + WS_Y;
            const float* g2 = ARG(21) + (size_t)l * D; const float* b2 = ARG(22) + (size_t)l * D;
            bf16* hb_dst = HB;
            if (rep_ > 0) { hb_dst = (bf16*)(ws + WS_S0 + 5 * SLOT); }
#define MOE_ROW(v, m) do { const v4i ti = tokinfo[m]; \
                const int e0 = ti.x >> 15, e1 = ti.y >> 15; const size_t r0 = (size_t)TP[e0] * 256 + (ti.x & (CAP - 1)), r1 = (size_t)TP[e1] * 256 + (ti.y & (CAP - 1)); \
                const float ga = __int_as_float(ti.z), gb = __int_as_float(ti.w); f32x4 y0[4], y1[4]; \
                load_row_bf16(HB + (size_t)(m) * D, v, lanel); load_row_fp8(Y + r0 * D, y0, lanel); load_row_fp8(Y + r1 * D, y1, lanel); \
                _Pragma("unroll") for (int j = 0; j < 4; ++j) v[j] = v[j] * DN_ALPHA + y0[j] * ga + y1[j] * gb; } while (0)
            const bool last_layer = (l + 1 == DEPTH);
            for (int m = gwl; m < M; m += 4 * NGWl) { const int m2 = m + NGWl, m3 = m + 2 * NGWl, m4 = m + 3 * NGWl; f32x4 v[4], w[4], x2[4], x3[4];
                MOE_ROW(v, m); MOE_ROW(w, m2); MOE_ROW(x2, m3); MOE_ROW(x3, m4);
                ln16(v, g2, b2, lanel); ln16(w, g2, b2, lanel); ln16(x2, g2, b2, lanel); ln16(x3, g2, b2, lanel);
                if (last_layer && rep_ == 0) { store_row_f32(out + (size_t)m * D, v, lanel); store_row_f32(out + (size_t)m2 * D, w, lanel); store_row_f32(out + (size_t)m3 * D, x2, lanel); store_row_f32(out + (size_t)m4 * D, x3, lanel); }
                else { store_row_bf16(hb_dst + (size_t)m * D, v, lanel); store_row_bf16(hb_dst + (size_t)m2 * D, w, lanel); store_row_bf16(hb_dst + (size_t)m3 * D, x2, lanel); store_row_bf16(hb_dst + (size_t)m4 * D, x3, lanel);
                    unsigned char* h8 = ws + WS_HB8; store_row_fp8(h8 + (size_t)m * D, v, lanel); store_row_fp8(h8 + (size_t)m2 * D, w, lanel); store_row_fp8(h8 + (size_t)m3 * D, x2, lanel); store_row_fp8(h8 + (size_t)m4 * D, x3, lanel); } }
#undef MOE_ROW
            }
            if (l + 1 < DEPTH) { __syncthreads(); LAS float* scr = (LAS float*)(L + RING_OFF + wave * TSCR_BYTES);
                _Pragma("unroll 1") for (int rep_ = 0, nrep_ = launder_i(1 + ((REPEAT >> 11) & 1)); rep_ < nrep_; ++rep_) convert_weights(l + 1, scr, gwl, NGWl, lanel);
                GRID_BAR(); }
        }
    }
}

extern "C" void kernel_launch(void* const* d_in, const int* in_sizes, int n_in, void* d_out, int out_size, void* d_ws, size_t ws_size, hipStream_t stream) {
    static int grid = 0;
    if (grid == 0) {
        if (n_in != 23 || in_sizes[0] != M * D || out_size != M * D || ws_size < WS_END) { fprintf(stderr, "kernel_launch: unexpected shapes (n_in %d, in0 %d, out %d, ws %zu < %zu); nothing launched\n", n_in, n_in > 0 ? in_sizes[0] : -1, out_size, ws_size, (size_t)WS_END); grid = -1; return; }
        int dev = 0, cus = 0, per_cu = 0;
        if (hipGetDevice(&dev) != hipSuccess || hipDeviceGetAttribute(&cus, hipDeviceAttributeMultiprocessorCount, dev) != hipSuccess) { fprintf(stderr, "kernel_launch: device query failed\n"); grid = -1; return; }
        if (hipFuncSetAttribute((const void*)hybrid_fwd, hipFuncAttributeMaxDynamicSharedMemorySize, LDS_BYTES) != hipSuccess) { fprintf(stderr, "kernel_launch: hipFuncSetAttribute failed\n"); grid = -1; return; }
        if (hipOccupancyMaxActiveBlocksPerMultiprocessor(&per_cu, (const void*)hybrid_fwd, NWAVES * 64, LDS_BYTES) != hipSuccess || per_cu < 1) { fprintf(stderr, "kernel_launch: occupancy query reports %d workgroups per CU\n", per_cu); }
        (void)hipGetLastError();
        grid = cus;
    }
    if (grid < 0) return;
    if (hipMemsetAsync((char*)d_ws + WS_CTL, 0, CTL_ZERO_BYTES, stream) != hipSuccess) { fprintf(stderr, "kernel_launch: hipMemsetAsync failed\n"); return; }
    Ptrs a{};
    for (int i = 0; i < 23; ++i) a.in[i] = (const float*)d_in[i];
    a.out = (float*)d_out; a.ws = (unsigned char*)d_ws;
    hipLaunchKernelGGL(hybrid_fwd, dim3(grid), dim3(NWAVES * 64), LDS_BYTES, stream, a);
    const hipError_t le = hipPeekAtLastError();
    if (le != hipSuccess) fprintf(stderr, "kernel_launch: launch failed: %s\n", hipGetErrorName(le));
}
```
